# Optimizing an MI355X kernel written in HIP

```python
import math
import jax
import jax.numpy as jnp
from jax import lax
import numpy as np

D_MODEL = 1024
BATCH = 4
SEQ = 8192
DEPTH = 2

HEAD_DIM = 64
Q_BLOCK = 128
RMS_EPS = 1e-6
D_FF = 4 * D_MODEL
NEG_INF = -1e30
FORCE_SCORE = 1e6

SB_HEADS = D_MODEL // (2 * HEAD_DIM)
SB_WIDTH = SB_HEADS * HEAD_DIM
DIFF_HEADS = D_MODEL // (4 * HEAD_DIM)
DIFF_WIDTH = DIFF_HEADS * 2 * HEAD_DIM
EVEN_IN = 3 * SB_WIDTH + 3 * DIFF_WIDTH
EVEN_OUT = SB_WIDTH + DIFF_WIDTH

NSA_HEADS = D_MODEL // HEAD_DIM
NSA_GROUPS = 4
NSA_HPG = NSA_HEADS // NSA_GROUPS
NSA_Q_WIDTH = NSA_HEADS * HEAD_DIM
NSA_KV_WIDTH = NSA_GROUPS * HEAD_DIM
CMP_LEN = 32
CMP_STRIDE = 16
CMP_HIDDEN = 4 * HEAD_DIM
SEL_LEN = 64
SEL_TOPK = 16
WINDOW = 512
N_GATES = 3
ODD_IN = NSA_Q_WIDTH + 6 * NSA_KV_WIDTH + N_GATES * NSA_HEADS

N_EVEN = (DEPTH + 1) // 2
N_ODD = DEPTH // 2

kernel_name = "hybrid_sb_diff_nsa_trunk"


def rmsnorm(x, g):
    x32 = x.astype(jnp.float32)
    y = x32 * lax.rsqrt(jnp.mean(x32 * x32, axis=-1, keepdims=True) + RMS_EPS)
    return (y * g.astype(jnp.float32)).astype(x.dtype)


def alibi_slopes(n_heads):
    return jnp.exp2(-8.0 * (jnp.arange(n_heads, dtype=jnp.float32) + 1.0) / n_heads)


def sweep_query_blocks(block_fn, seq):
    out = lax.map(block_fn, jnp.arange(seq // Q_BLOCK))
    out = jnp.moveaxis(out, 0, 1)
    return out.reshape((out.shape[0], seq) + out.shape[3:])


def stick_breaking_attention(q, k, v):
    S = q.shape[1]
    scale = q.shape[-1] ** -0.5
    kpos = jnp.arange(S)

    def block(i):
        t0 = i * Q_BLOCK
        qb = lax.dynamic_slice_in_dim(q, t0, Q_BLOCK, axis=1)
        tpos = t0 + jnp.arange(Q_BLOCK)
        past = kpos[None, :] < tpos[:, None]
        z = jnp.einsum("bqhd,bkhd->bhqk", qb, k).astype(jnp.float32) * scale
        log_beta = jax.nn.log_sigmoid(z)
        log_rem = jnp.where(past, jax.nn.log_sigmoid(-z), 0.0)
        tail = lax.cumsum(log_rem, axis=3, reverse=True) - log_rem
        w = jnp.where(past, jnp.exp(log_beta + tail), 0.0)
        return jnp.einsum("bhqk,bkhd->bqhd", w.astype(v.dtype), v)

    return sweep_query_blocks(block, S)


def differential_attention(q, k, v, lam, slopes):
    S = q.shape[1]
    scale = q.shape[-1] ** -0.5
    kpos = jnp.arange(S)

    def block(i):
        t0 = i * Q_BLOCK
        qb = lax.dynamic_slice_in_dim(q, t0, Q_BLOCK, axis=1)
        tpos = t0 + jnp.arange(Q_BLOCK)
        dist = (tpos[:, None] - kpos[None, :]).astype(jnp.float32)
        s = jnp.einsum("bqhcd,bkhcd->bhcqk", qb, k).astype(jnp.float32) * scale
        s = jnp.where(dist >= 0, s - slopes[None, :, None, None, None] * dist, NEG_INF)
        p = jax.nn.softmax(s, axis=-1)
        a = p[:, :, 0] - lam * p[:, :, 1]
        return jnp.einsum("bhqk,bkhe->bqhe", a.astype(v.dtype), v)

    return sweep_query_blocks(block, S)


def sb_diff_mixer(h, w_in, lam_q1, lam_k1, lam_q2, lam_k2, subln, w_out, layer):
    B, S, _ = h.shape
    proj = h @ w_in
    sb_q, sb_k, sb_v, df_q, df_k, df_v = jnp.split(proj, 6, axis=-1)
    sb_shape = (B, S, SB_HEADS, HEAD_DIM)
    o_sb = stick_breaking_attention(sb_q.reshape(sb_shape), sb_k.reshape(sb_shape),
                                    sb_v.reshape(sb_shape))
    lambda_init = 0.8 - 0.6 * math.exp(-0.3 * layer)
    lam = (jnp.exp(jnp.sum(lam_q1.astype(jnp.float32) * lam_k1.astype(jnp.float32)))
           - jnp.exp(jnp.sum(lam_q2.astype(jnp.float32) * lam_k2.astype(jnp.float32)))
           + lambda_init)
    qk_shape = (B, S, DIFF_HEADS, 2, HEAD_DIM)
    o_df = differential_attention(df_q.reshape(qk_shape), df_k.reshape(qk_shape),
                                  df_v.reshape(B, S, DIFF_HEADS, 2 * HEAD_DIM),
                                  lam, alibi_slopes(DIFF_HEADS))
    o_df = rmsnorm(o_df, subln) * (1.0 - lambda_init)
    o = jnp.concatenate([o_sb.reshape(B, S, SB_WIDTH), o_df.reshape(B, S, DIFF_WIDTH)], axis=-1)
    return o @ w_out


def compress(t, pos, w1, w2):
    B, S, G, Dh = t.shape
    ratio = CMP_LEN // CMP_STRIDE
    n_chunks = S // CMP_STRIDE
    n_cmp = n_chunks - ratio + 1
    chunks = t.reshape(B, n_chunks, CMP_STRIDE, G, Dh)
    blocks = jnp.concatenate([chunks[:, r:r + n_cmp] for r in range(ratio)], axis=2)
    blocks = blocks + pos[None, None, :, None, :]
    flat = jnp.moveaxis(blocks, 3, 2).reshape(B, n_cmp, G, CMP_LEN * Dh)
    return jax.nn.gelu(flat @ w1) @ w2


def nsa_attention(q, kc, vc, ks, vs, kw, vw, gates, slopes):
    B, S, H, Dh = q.shape
    G = kc.shape[2]
    hpg = H // G
    n_cmp = kc.shape[1]
    n_sel = S // SEL_LEN
    topk = min(SEL_TOPK, n_sel)
    scale = Dh ** -0.5
    slope_g = slopes.reshape(G, hpg)
    qg = q.reshape(B, S, G, hpg, Dh)
    gg = gates.reshape(B, S, G, hpg, N_GATES)
    cmp_start = jnp.arange(n_cmp) * CMP_STRIDE
    cmp_end = cmp_start + CMP_LEN - 1
    sel_ids = jnp.arange(n_sel)
    sel_start = sel_ids * SEL_LEN
    overlap = ((cmp_start[:, None] < sel_start[None, :] + SEL_LEN)
               & (sel_start[None, :] <= cmp_end[:, None])).astype(jnp.float32)
    ks_bg = jnp.moveaxis(ks.reshape(B, n_sel, SEL_LEN, G, Dh), 3, 1)
    vs_bg = jnp.moveaxis(vs.reshape(B, n_sel, SEL_LEN, G, Dh), 3, 1)
    gather_blocks = jax.vmap(jax.vmap(lambda blk, idx: blk[idx]))
    pad = ((0, 0), (WINDOW, 0), (0, 0), (0, 0))
    kw_pad = jnp.pad(kw, pad)
    vw_pad = jnp.pad(vw, pad)
    win_off = jnp.arange(Q_BLOCK + WINDOW) - WINDOW
    sel_off = jnp.arange(SEL_LEN)

    def block(i):
        t0 = i * Q_BLOCK
        tpos = t0 + jnp.arange(Q_BLOCK)
        qb = lax.dynamic_slice_in_dim(qg, t0, Q_BLOCK, axis=1)
        gb = lax.dynamic_slice_in_dim(gg, t0, Q_BLOCK, axis=1)
        dc = (tpos[:, None] - cmp_end[None, :]).astype(jnp.float32)
        valid_c = dc >= 0
        sc = jnp.einsum("bqgrd,bngd->bgrqn", qb, kc).astype(jnp.float32) * scale
        sc = jnp.where(valid_c, sc - slope_g[None, :, :, None, None] * dc, NEG_INF)
        pc = jax.nn.softmax(sc, axis=-1) * jnp.any(valid_c, axis=-1)[:, None].astype(jnp.float32)
        o_cmp = jnp.einsum("bgrqn,bngd->bqgrd", pc.astype(vc.dtype), vc)
        imp = jnp.einsum("bgrqn,ns->bgqs", pc, overlap)
        cur = tpos // SEL_LEN
        forced = ((sel_ids[None, :] == 0) | (sel_ids[None, :] == cur[:, None])
                  | (sel_ids[None, :] == cur[:, None] - 1))
        imp = jnp.where(forced, FORCE_SCORE, imp)
        imp = jnp.where(sel_ids[None, :] <= cur[:, None], imp, -1.0)
        top_val, top_idx = lax.top_k(imp, topk)
        k_sel = gather_blocks(ks_bg, top_idx)
        v_sel = gather_blocks(vs_bg, top_idx)
        d_sel = (tpos[None, None, :, None, None]
                 - (top_idx[..., None] * SEL_LEN + sel_off)).astype(jnp.float32)
        valid_s = (d_sel >= 0) & (top_val >= 0)[..., None]
        ss = jnp.einsum("bqgrd,bgqkld->bgrqkl", qb, k_sel).astype(jnp.float32) * scale
        ss = jnp.where(valid_s[:, :, None],
                       ss - slope_g[None, :, :, None, None, None] * d_sel[:, :, None], NEG_INF)
        ps = jax.nn.softmax(ss.reshape(ss.shape[:4] + (-1,)), axis=-1).reshape(ss.shape)
        o_sel = jnp.einsum("bgrqkl,bgqkld->bqgrd", ps.astype(vs.dtype), v_sel)
        kwb = lax.dynamic_slice_in_dim(kw_pad, t0, Q_BLOCK + WINDOW, axis=1)
        vwb = lax.dynamic_slice_in_dim(vw_pad, t0, Q_BLOCK + WINDOW, axis=1)
        kpos_w = t0 + win_off
        dw = tpos[:, None] - kpos_w[None, :]
        valid_w = (dw >= 0) & (dw < WINDOW) & (kpos_w[None, :] >= 0)
        sw = jnp.einsum("bqgrd,bkgd->bgrqk", qb, kwb).astype(jnp.float32) * scale
        sw = jnp.where(valid_w, sw - slope_g[None, :, :, None, None] * dw.astype(jnp.float32), NEG_INF)
        pw = jax.nn.softmax(sw, axis=-1)
        o_win = jnp.einsum("bgrqk,bkgd->bqgrd", pw.astype(vw.dtype), vwb)
        return gb[..., 0:1] * o_cmp + gb[..., 1:2] * o_sel + gb[..., 2:3] * o_win

    out = sweep_query_blocks(block, S)
    return out.reshape(B, S, H * Dh)


def nsa_mixer(h, w_in, cmp_pos_k, cmp_k_w1, cmp_k_w2, cmp_pos_v, cmp_v_w1, cmp_v_w2, w_out):
    B, S, _ = h.shape
    proj = h @ w_in
    cuts = [NSA_Q_WIDTH + j * NSA_KV_WIDTH for j in range(7)]
    q, kc, vc, ks, vs, kw, vw, g = jnp.split(proj, cuts, axis=-1)
    kv_shape = (B, S, NSA_GROUPS, HEAD_DIM)
    kc = compress(kc.reshape(kv_shape), cmp_pos_k, cmp_k_w1, cmp_k_w2)
    vc = compress(vc.reshape(kv_shape), cmp_pos_v, cmp_v_w1, cmp_v_w2)
    gates = jax.nn.sigmoid(g.astype(jnp.float32)).astype(h.dtype).reshape(B, S, NSA_HEADS, N_GATES)
    o = nsa_attention(q.reshape(B, S, NSA_HEADS, HEAD_DIM), kc, vc,
                      ks.reshape(kv_shape), vs.reshape(kv_shape),
                      kw.reshape(kv_shape), vw.reshape(kv_shape),
                      gates, alibi_slopes(NSA_HEADS))
    return o @ w_out


def squared_relu_mlp(h, w1, w2):
    return jnp.square(jax.nn.relu(h @ w1)) @ w2


def setup_inputs(seed: int = 0) -> dict:
    key = jax.random.key(seed)
    ks = jax.random.split(key, 21)

    def nrm(k, shape, scale):
        return jax.random.normal(k, shape, jnp.float32) * scale

    return {
        "x": nrm(ks[0], (BATCH, SEQ, D_MODEL), 1.0),
        "attn_norm": 1.0 + nrm(ks[1], (DEPTH, D_MODEL), 0.02),
        "mlp_norm": 1.0 + nrm(ks[2], (DEPTH, D_MODEL), 0.02),
        "final_norm": 1.0 + nrm(ks[3], (D_MODEL,), 0.02),
        "ev_w_in": nrm(ks[4], (N_EVEN, D_MODEL, EVEN_IN), D_MODEL ** -0.5),
        "ev_lam_q1": nrm(ks[5], (N_EVEN, HEAD_DIM), 0.1),
        "ev_lam_k1": nrm(ks[6], (N_EVEN, HEAD_DIM), 0.1),
        "ev_lam_q2": nrm(ks[7], (N_EVEN, HEAD_DIM), 0.1),
        "ev_lam_k2": nrm(ks[8], (N_EVEN, HEAD_DIM), 0.1),
        "ev_subln": 1.0 + nrm(ks[9], (N_EVEN, 2 * HEAD_DIM), 0.02),
        "ev_w_out": nrm(ks[10], (N_EVEN, EVEN_OUT, D_MODEL), EVEN_OUT ** -0.5),
        "od_w_in": nrm(ks[11], (N_ODD, D_MODEL, ODD_IN), D_MODEL ** -0.5),
        "od_cmp_pos_k": nrm(ks[12], (N_ODD, CMP_LEN, HEAD_DIM), 0.1),
        "od_cmp_k_w1": nrm(ks[13], (N_ODD, CMP_LEN * HEAD_DIM, CMP_HIDDEN), (CMP_LEN * HEAD_DIM) ** -0.5),
        "od_cmp_k_w2": nrm(ks[14], (N_ODD, CMP_HIDDEN, HEAD_DIM), CMP_HIDDEN ** -0.5),
        "od_cmp_pos_v": nrm(ks[15], (N_ODD, CMP_LEN, HEAD_DIM), 0.1),
        "od_cmp_v_w1": nrm(ks[16], (N_ODD, CMP_LEN * HEAD_DIM, CMP_HIDDEN), (CMP_LEN * HEAD_DIM) ** -0.5),
        "od_cmp_v_w2": nrm(ks[17], (N_ODD, CMP_HIDDEN, HEAD_DIM), CMP_HIDDEN ** -0.5),
        "od_w_out": nrm(ks[18], (N_ODD, NSA_Q_WIDTH, D_MODEL), NSA_Q_WIDTH ** -0.5),
        "mlp_w1": nrm(ks[19], (DEPTH, D_MODEL, D_FF), D_MODEL ** -0.5),
        "mlp_w2": nrm(ks[20], (DEPTH, D_FF, D_MODEL), D_FF ** -0.5),
    }


def reference(x, attn_norm, mlp_norm, final_norm, ev_w_in, ev_lam_q1, ev_lam_k1, ev_lam_q2,
              ev_lam_k2, ev_subln, ev_w_out, od_w_in, od_cmp_pos_k, od_cmp_k_w1, od_cmp_k_w2,
              od_cmp_pos_v, od_cmp_v_w1, od_cmp_v_w2, od_w_out, mlp_w1, mlp_w2):
    for layer in range(DEPTH):
        h = rmsnorm(x, attn_norm[layer])
        if layer % 2 == 0:
            e = layer // 2
            mix = sb_diff_mixer(h, ev_w_in[e], ev_lam_q1[e], ev_lam_k1[e], ev_lam_q2[e],
                                ev_lam_k2[e], ev_subln[e], ev_w_out[e], layer)
        else:
            o = layer // 2
            mix = nsa_mixer(h, od_w_in[o], od_cmp_pos_k[o], od_cmp_k_w1[o], od_cmp_k_w2[o],
                            od_cmp_pos_v[o], od_cmp_v_w1[o], od_cmp_v_w2[o], od_w_out[o])
        x = x + mix
        x = x + squared_relu_mlp(rmsnorm(x, mlp_norm[layer]), mlp_w1[layer], mlp_w2[layer])
    return rmsnorm(x, final_norm)
```

```cpp
#define PROBE_DUP 0
#include <hip/hip_runtime.h>
#include <hip/hip_cooperative_groups.h>
#include <cstdio>
#include <cstdint>
namespace cg = cooperative_groups;
namespace pg8 {
#define PG8_LAS __attribute__((address_space(3)))
typedef unsigned short bf16_t;
typedef short bf16x8 __attribute__((ext_vector_type(8)));
typedef float f32x4 __attribute__((ext_vector_type(4)));
typedef unsigned u32x4 __attribute__((ext_vector_type(4)));
constexpr int BM = 256, BK = 64, HALF = 128, HTB = HALF * BK * 2  , STAGE_BYTES = 8 * HTB, NXCD = 8, WGM = 2;

__host__ __device__ __forceinline__ int lds_byte(int r, int c) { const int st = (r >> 4) * 2 + (c >> 5), rr = r & 15, cc = c & 31, ob = rr * 64 + cc * 2; return st * 1024 + (ob ^ (((ob >> 9) & 1) << 5)); }
__host__ __device__ __forceinline__ void stage_rc(int b, int& R, int& C) { const int st = b / 1024, sb = b % 1024, swz = sb ^ (((sb >> 9) & 1) << 5); R = (st >> 1) * 16 + swz / 64; C = (st & 1) * 32 + (swz % 64) / 2; }
__host__ __device__ __forceinline__ int perm32(int rho) { const int n = rho >> 4, i = rho & 15; return 8 * (i >> 2) + 4 * n + (i & 3); }

struct Unit { int pm, pn; };
struct Gemm { const bf16_t* A; const bf16_t* Bt; int M, N, K; };

struct StaticOrder {
    int nM, nN, nwg, G, c;
    __host__ __device__ void init(int M, int N, int G_, int c_) { nM = M / BM; nN = N / BM; nwg = nM * nN; G = G_; c = c_; }
    __host__ __device__ bool next(int i, Unit& u) const {
        const long L = (long)i * G + c; if (L >= nwg) return false;
        int wgid = (int)L; { const int q = nwg / NXCD, r = nwg % NXCD, xcd = wgid % NXCD, off = wgid / NXCD; wgid = (xcd < r ? xcd * (q + 1) : r * (q + 1) + (xcd - r) * q) + off; }
        const int nig = WGM * nN, gid = wgid / nig, fm = gid * WGM, gsz = (nM - fm) < WGM ? (nM - fm) : WGM;
        u.pm = fm + ((wgid % nig) % gsz); u.pn = (wgid % nig) / gsz; return true;
    }
    __device__ __forceinline__ void a_ready(const Unit&) const {}
    __device__ __forceinline__ void done(const Unit&) const {}
};

__device__ __forceinline__ unsigned cvt_pk_bf16(float lo, float hi) { unsigned r; asm volatile("v_cvt_pk_bf16_f32 %0, %1, %2" : "=v"(r) : "v"(lo), "v"(hi)); return r; }

template <class Epi, class Sched, bool ALIGN_EPI = false, bool SP2 = false>
__device__ __forceinline__ void gemm_phase(PG8_LAS unsigned char* lds, const Gemm g, const Sched& S, const Epi& E) {
    const int tid = threadIdx.x, wid = __builtin_amdgcn_readfirstlane(tid >> 6), lane = tid & 63, wr = wid >> 2, wc = wid & 3, fr = lane & 15, fq = lane >> 4;
    const int K = g.K, nt = K / BK;
    unsigned voffA[2], voffB[2];
#pragma unroll
    for (int i = 0; i < 2; ++i) { int R, C; stage_rc(tid * 16 + i * 8192, R, C); const int Rb = Epi::PERM ? ((R & ~31) + perm32(R & 31)) : R;
        voffA[i] = (unsigned)(R * K + C) * 2u; voffB[i] = (unsigned)(Rb * K + C) * 2u; }
    const size_t kstep = (size_t)(BK * 2);
    const size_t hstep = (size_t)HALF * K * 2;
    const size_t tstep = 2 * hstep;
    const unsigned ldsw = (unsigned)wid * 1024u;
    const int aoff = lds_byte(wr * 64 + fr, fq * 8), boff = lds_byte(wc * 32 + fr, fq * 8);
#define PG8_SA(b, h) (((b) * 2 + (h)) * HTB)
#define PG8_SB(b, h) ((4 + (b) * 2 + (h)) * HTB)
#define PG8_STAGE(bufoff, gbase, voff) do { _Pragma("unroll") for (int _i = 0; _i < 2; ++_i) \
        __builtin_amdgcn_global_load_lds((const unsigned*)((const char*)(gbase) + (voff)[_i]), (PG8_LAS unsigned*)(lds + (bufoff) + ldsw + _i * 8192), 16, 0, 0); } while (0)
#define PG8_LDA(dst, b, h) do { _Pragma("unroll") for (int m = 0; m < 4; ++m) _Pragma("unroll") for (int k = 0; k < 2; ++k) dst[m][k] = *(const PG8_LAS bf16x8*)(lds + PG8_SA(b, h) + aoff + m * 2048 + k * 1024); } while (0)
#define PG8_LDB(dst, b, h) do { _Pragma("unroll") for (int n = 0; n < 2; ++n) _Pragma("unroll") for (int k = 0; k < 2; ++k) dst[n][k] = *(const PG8_LAS bf16x8*)(lds + PG8_SB(b, h) + boff + n * 2048 + k * 1024); } while (0)
#define PG8_MMA(ai, bj, At, Bt) do { __builtin_amdgcn_s_setprio(1); _Pragma("unroll") for (int m = 0; m < 4; ++m) _Pragma("unroll") for (int n = 0; n < 2; ++n) _Pragma("unroll") for (int k = 0; k < 2; ++k) \
        acc[ai][bj][m][n] = __builtin_amdgcn_mfma_f32_16x16x32_bf16(Bt[n][k], At[m][k], acc[ai][bj][m][n], 0, 0, 0); __builtin_amdgcn_s_setprio(0); } while (0)
#define PG8_WAIT_V(n) asm volatile("s_waitcnt vmcnt(" #n ")" ::: "memory")
#define PG8_WAIT_L(n) asm volatile("s_waitcnt lgkmcnt(" #n ")" ::: "memory")
#define PG8_BAR __builtin_amdgcn_s_barrier()
#define PG8_SCHED __builtin_amdgcn_sched_barrier(0)
    Unit cur, nxt; int ui = 0;
    if (!S.next(0, cur)) return;
    f32x4 acc[2][2][4][2];
#pragma unroll
    for (int a = 0; a < 2; ++a)
#pragma unroll
        for (int b = 0; b < 2; ++b)
#pragma unroll
            for (int m = 0; m < 4; ++m)
#pragma unroll
                for (int n = 0; n < 2; ++n) acc[a][b][m][n] = (f32x4){0.f, 0.f, 0.f, 0.f};
    bf16x8 At[4][2], B0[2][2], B1[2][2];
    const char* cA = (const char*)g.A + (size_t)cur.pm * tstep; const char* cB = (const char*)g.Bt + (size_t)cur.pn * tstep;
    S.a_ready(cur);
    if constexpr (SP2) {
        PG8_STAGE(PG8_SB(0, 0), cB, voffB); PG8_STAGE(PG8_SB(0, 1), cB + hstep, voffB); PG8_STAGE(PG8_SA(0, 0), cA, voffA); PG8_STAGE(PG8_SA(0, 1), cA + hstep, voffA);
        if (wr == 1) PG8_BAR;
        PG8_WAIT_V(2); PG8_BAR;
        PG8_STAGE(PG8_SB(1, 0), cB + kstep, voffB); PG8_STAGE(PG8_SA(1, 0), cA + kstep, voffA); PG8_STAGE(PG8_SB(1, 1), cB + hstep + kstep, voffB);
        PG8_WAIT_V(6); PG8_BAR;
    } else {
        PG8_STAGE(PG8_SB(0, 0), cB, voffB); PG8_STAGE(PG8_SA(0, 0), cA, voffA); PG8_STAGE(PG8_SB(0, 1), cB + hstep, voffB); PG8_STAGE(PG8_SA(0, 1), cA + hstep, voffA);
        if (wr == 1) PG8_BAR;
        PG8_WAIT_V(4); PG8_BAR;
        PG8_STAGE(PG8_SB(1, 0), cB + kstep, voffB); PG8_STAGE(PG8_SA(1, 0), cA + kstep, voffA); PG8_STAGE(PG8_SB(1, 1), cB + hstep + kstep, voffB);
        PG8_WAIT_V(6); PG8_BAR;
    }
    for (;;) {
        const bool has_next = S.next(ui + 1, nxt);
        const char* nA = has_next ? (const char*)g.A + (size_t)nxt.pm * tstep : cA; const char* nB = has_next ? (const char*)g.Bt + (size_t)nxt.pn * tstep : cB;
        for (int t = 0; t < nt; t += 2) {
            const bool last = (t == nt - 2);
            const char* a1 = cA + (size_t)(t + 1) * kstep;
            const char* a2 = last ? nA : cA + (size_t)(t + 2) * kstep; const char* b2 = last ? nB : cB + (size_t)(t + 2) * kstep;
            const char* a3 = a2 + kstep; const char* b3 = b2 + kstep;
            if (last && has_next) S.a_ready(nxt);
            if constexpr (SP2) {
            PG8_LDB(B0, 0, 0); PG8_LDB(B1, 0, 1); PG8_SCHED; PG8_LDA(At, 0, 0); PG8_STAGE(PG8_SA(1, 1), a1 + hstep, voffA);
            PG8_WAIT_V(8); PG8_WAIT_L(0); PG8_BAR; PG8_MMA(0, 0, At, B0); PG8_MMA(0, 1, At, B1); PG8_BAR; PG8_SCHED;
            PG8_LDA(At, 0, 1); PG8_STAGE(PG8_SB(0, 0), b2, voffB); PG8_STAGE(PG8_SB(0, 1), b2 + hstep, voffB); PG8_STAGE(PG8_SA(0, 0), a2, voffA);
            PG8_WAIT_V(8); PG8_WAIT_L(0); PG8_BAR; PG8_MMA(1, 0, At, B0); PG8_MMA(1, 1, At, B1); PG8_BAR; PG8_SCHED;
            PG8_LDB(B0, 1, 0); PG8_LDB(B1, 1, 1); PG8_SCHED; PG8_LDA(At, 1, 0); PG8_STAGE(PG8_SA(0, 1), a2 + hstep, voffA);
            PG8_WAIT_V(8); PG8_WAIT_L(0); PG8_BAR; PG8_MMA(0, 0, At, B0); PG8_MMA(0, 1, At, B1); PG8_BAR; PG8_SCHED;
            PG8_LDA(At, 1, 1); PG8_STAGE(PG8_SB(1, 0), b3, voffB); PG8_STAGE(PG8_SB(1, 1), b3 + hstep, voffB); PG8_STAGE(PG8_SA(1, 0), a3, voffA);
            PG8_WAIT_V(8); PG8_WAIT_L(0); PG8_BAR; PG8_MMA(1, 0, At, B0); PG8_MMA(1, 1, At, B1); PG8_BAR; PG8_SCHED;
            } else {
            PG8_LDB(B0, 0, 0); PG8_SCHED; PG8_LDA(At, 0, 0); PG8_STAGE(PG8_SA(1, 1), a1 + hstep, voffA);
            PG8_WAIT_L(8); PG8_BAR; PG8_WAIT_L(0); PG8_MMA(0, 0, At, B0); PG8_BAR; PG8_SCHED;
            PG8_LDB(B1, 0, 1); PG8_STAGE(PG8_SB(0, 0), b2, voffB);
            PG8_BAR; PG8_WAIT_L(0); PG8_MMA(0, 1, At, B1); PG8_BAR;
            PG8_LDA(At, 0, 1); PG8_STAGE(PG8_SA(0, 0), a2, voffA);
            PG8_BAR; PG8_WAIT_L(0); PG8_MMA(1, 0, At, B0); PG8_BAR; PG8_SCHED;
            PG8_STAGE(PG8_SB(0, 1), b2 + hstep, voffB);
            PG8_WAIT_V(6); PG8_BAR; PG8_MMA(1, 1, At, B1); PG8_BAR;
            PG8_LDB(B0, 1, 0); PG8_SCHED; PG8_LDA(At, 1, 0); PG8_STAGE(PG8_SA(0, 1), a2 + hstep, voffA);
            PG8_WAIT_L(8); PG8_BAR; PG8_WAIT_L(0); PG8_MMA(0, 0, At, B0); PG8_BAR; PG8_SCHED;
            PG8_LDB(B1, 1, 1); PG8_STAGE(PG8_SB(1, 0), b3, voffB);
            PG8_BAR; PG8_WAIT_L(0); PG8_MMA(0, 1, At, B1); PG8_BAR;
            PG8_LDA(At, 1, 1); PG8_STAGE(PG8_SA(1, 0), a3, voffA);
            PG8_BAR; PG8_WAIT_L(0); PG8_MMA(1, 0, At, B0); PG8_BAR; PG8_SCHED;
            PG8_STAGE(PG8_SB(1, 1), b3 + hstep, voffB);
            PG8_WAIT_V(6); PG8_BAR; PG8_MMA(1, 1, At, B1); PG8_BAR;
            }
        }
        if constexpr (ALIGN_EPI) { if (wr == 0) PG8_BAR; }
        if constexpr (!Epi::AFTER_DRAIN) { E(acc, cur, wr, wc, fr, fq); S.done(cur); }
        if (!has_next) break;
#pragma unroll
        for (int a = 0; a < 2; ++a)
#pragma unroll
            for (int b = 0; b < 2; ++b)
#pragma unroll
                for (int m = 0; m < 4; ++m)
#pragma unroll
                    for (int n = 0; n < 2; ++n) acc[a][b][m][n] = (f32x4){0.f, 0.f, 0.f, 0.f};
        cur = nxt; cA = nA; cB = nB; ++ui;
        if constexpr (ALIGN_EPI) { if (wr == 1) PG8_BAR; }
    }
    PG8_WAIT_V(0);
    if constexpr (!ALIGN_EPI) { if (wr == 0) PG8_BAR; }
    PG8_BAR;
    if constexpr (Epi::AFTER_DRAIN) { E.fused(acc, cur, wr, wc, fr, fq, lds, wid, lane); S.done(cur); }
#undef PG8_SA
#undef PG8_SB
#undef PG8_STAGE
#undef PG8_LDA
#undef PG8_LDB
#undef PG8_MMA
#undef PG8_WAIT_V
#undef PG8_WAIT_L
#undef PG8_BAR
#undef PG8_SCHED
}
}
namespace pg8 {
typedef unsigned u32x2 __attribute__((ext_vector_type(2)));
__device__ __forceinline__ unsigned pkbf(float a, float b) { typedef float f2 __attribute__((ext_vector_type(2))); typedef __bf16 b2 __attribute__((ext_vector_type(2)));
    f2 v = {a, b}; b2 r = __builtin_convertvector(v, b2); return __builtin_bit_cast(unsigned, r); }
template <int ACT  , bool KMAX = false, int SCALE = 0, bool TILED = false  > struct EpiB {
    static constexpr bool PERM = true, AFTER_DRAIN = false;
    bf16_t* O; int ldc; unsigned* kmax; int kpn0, kpn1; const float* ss; bf16_t* kfrag; int kfpn;
    __device__ __forceinline__ void operator()(const f32x4 (&acc)[2][2][4][2], const Unit& u, int wr, int wc, int fr, int fq) const {
        const int row0 = u.pm * BM + wr * 64 + fr; const int col0 = u.pn * BM + wc * 32 + 8 * fq;
        float rsr[2][4]; f32x4 rsc[2][2];
        if (SCALE == 1) {
#pragma unroll
            for (int ai = 0; ai < 2; ++ai)
#pragma unroll
                for (int m = 0; m < 4; ++m) rsr[ai][m] = ss[row0 + ai * HALF + m * 16]; }
        if (SCALE == 2) {
#pragma unroll
            for (int bj = 0; bj < 2; ++bj)
#pragma unroll
                for (int n = 0; n < 2; ++n) rsc[bj][n] = *(const f32x4*)(ss + col0 + bj * HALF + 4 * n); }
        if (KMAX) if (u.pn >= kpn0 && u.pn < kpn1) {
#pragma unroll
            for (int bj = 0; bj < 2; ++bj) { float mx = 0.f;
#pragma unroll
                for (int ai = 0; ai < 2; ++ai)
#pragma unroll
                    for (int m = 0; m < 4; ++m) { const f32x4 a = acc[ai][bj][m][0], b = acc[ai][bj][m][1];
                        float q = (a[0] * a[0] + a[1] * a[1]) + (a[2] * a[2] + a[3] * a[3]) + (b[0] * b[0] + b[1] * b[1]) + (b[2] * b[2] + b[3] * b[3]);
                        if (SCALE == 1) q *= rsr[ai][m] * rsr[ai][m];
                        q += __shfl_xor(q, 16); q += __shfl_xor(q, 32); mx = fmaxf(mx, q); }
                mx = fmaxf(mx, __shfl_xor(mx, 1)); mx = fmaxf(mx, __shfl_xor(mx, 2)); mx = fmaxf(mx, __shfl_xor(mx, 4)); mx = fmaxf(mx, __shfl_xor(mx, 8));
                if (fr == 0 && fq == 0) atomicMax(kmax + (u.pm >> 5) * ((kpn1 - kpn0) * 8) + (u.pn - kpn0) * 8 + bj * 4 + wc, __float_as_uint(mx)); }
        }
#pragma unroll
        for (int ai = 0; ai < 2; ++ai)
#pragma unroll
            for (int m = 0; m < 4; ++m) { bf16_t* rowp = O + (size_t)(row0 + ai * HALF + m * 16) * ldc + col0;
#pragma unroll
                for (int bj = 0; bj < 2; ++bj) { f32x4 v0 = acc[ai][bj][m][0], v1 = acc[ai][bj][m][1];
                    if (SCALE == 1) { v0 *= rsr[ai][m]; v1 *= rsr[ai][m]; }
                    if (SCALE == 2) { v0 *= rsc[bj][0]; v1 *= rsc[bj][1]; }
                    if (ACT == 1) {
#pragma unroll
                        for (int e = 0; e < 4; ++e) { float a = fmaxf(v0[e], 0.f), b = fmaxf(v1[e], 0.f); v0[e] = a * a; v1[e] = b * b; } }
                    u32x4 w; w.x = pkbf(v0[0], v0[1]); w.y = pkbf(v0[2], v0[3]); w.z = pkbf(v1[0], v1[1]); w.w = pkbf(v1[2], v1[3]);
                    if (TILED) { const int f = row0 + ai * HALF + m * 16, tok = col0 + bj * HALF, d = f & 63, q = (tok & 31) >> 3;
                        *(u32x4*)(O + ((size_t)((f >> 6) * 1024 + (tok >> 5)) * 2048) + (((((d >> 5) * 2 + (q >> 1)) * 2 + (q & 1)) * 32 + (d & 31)) * 8)) = w; }
                    else if (kfrag != nullptr && u.pn == kfpn) { const int tok = row0 + ai * HALF + m * 16, cc = wc * 32 + 8 * fq + bj * HALF, d0 = cc & 63, ky = tok & 31;
                        const int rho = 16 * (ky >> 4) + 8 * ((ky >> 2) & 1) + 4 * ((ky >> 3) & 1) + (ky & 3);
                        *(u32x4*)(kfrag + ((size_t)((cc >> 6) * 1024 + (tok >> 5)) * 2048) + (((d0 >> 4) * 64 + ((d0 >> 3) & 1) * 32 + rho) * 8)) = w; }
                    else *(u32x4*)(rowp + bj * HALF) = w; } }
    }
};
template <bool NORM> struct EpiR {
    static constexpr bool PERM = false, AFTER_DRAIN = false;
    const float* base; float* out; int ldc; bf16_t* xb; float* ss;
    __device__ __forceinline__ void operator()(const f32x4 (&acc)[2][2][4][2], const Unit& u, int wr, int wc, int fr, int fq) const {
        const int col0 = u.pn * BM + wc * 32 + 4 * fq;
#pragma unroll
        for (int ai = 0; ai < 2; ++ai)
#pragma unroll
            for (int m = 0; m < 4; ++m) { const int r = ai * HALF + wr * 64 + m * 16 + fr; const size_t off = (size_t)(u.pm * BM + r) * ldc + col0; float q = 0.f;
#pragma unroll
                for (int bj = 0; bj < 2; ++bj)
#pragma unroll
                    for (int n = 0; n < 2; ++n) { const f32x4 bs = *(const f32x4*)(base + off + bj * HALF + n * 16); const f32x4 o = bs + acc[ai][bj][m][n]; *(f32x4*)(out + off + bj * HALF + n * 16) = o;
                        if (NORM) { q += (o[0] * o[0] + o[1] * o[1]) + (o[2] * o[2] + o[3] * o[3]); u32x2 w; w.x = pkbf(o[0], o[1]); w.y = pkbf(o[2], o[3]); *(u32x2*)(xb + off + bj * HALF + n * 16) = w; } }
                if (NORM) { q += __shfl_xor(q, 16); q += __shfl_xor(q, 32); if (fq == 0) ss[(size_t)(u.pm * BM + r) * 16 + u.pn * 4 + wc] = q; } }
    }
};
template <bool NORM> struct EpiRb {
    static constexpr bool PERM = true, AFTER_DRAIN = false;
    bf16_t* xb; int ldc; float* ss;
    __device__ __forceinline__ void operator()(const f32x4 (&acc)[2][2][4][2], const Unit& u, int wr, int wc, int fr, int fq) const {
        const int col0 = u.pn * BM + wc * 32 + 8 * fq;
#pragma unroll
        for (int ai = 0; ai < 2; ++ai)
#pragma unroll
            for (int m = 0; m < 4; ++m) { const int r = ai * HALF + wr * 64 + m * 16 + fr; bf16_t* rowp = xb + (size_t)(u.pm * BM + r) * ldc + col0; float q = 0.f;
                u32x4 bw[2];
#pragma unroll
                for (int bj = 0; bj < 2; ++bj) bw[bj] = *(const u32x4*)(rowp + bj * HALF);
#pragma unroll
                for (int bj = 0; bj < 2; ++bj) { const u32x4 b = bw[bj]; const f32x4 a0 = acc[ai][bj][m][0], a1 = acc[ai][bj][m][1];
                    u32x4 w;
                    w.x = pkbf(__uint_as_float(b.x << 16) + a0[0], __uint_as_float(b.x & 0xffff0000u) + a0[1]);
                    w.y = pkbf(__uint_as_float(b.y << 16) + a0[2], __uint_as_float(b.y & 0xffff0000u) + a0[3]);
                    w.z = pkbf(__uint_as_float(b.z << 16) + a1[0], __uint_as_float(b.z & 0xffff0000u) + a1[1]);
                    w.w = pkbf(__uint_as_float(b.w << 16) + a1[2], __uint_as_float(b.w & 0xffff0000u) + a1[3]);
                    *(u32x4*)(rowp + bj * HALF) = w;
                    if (NORM) {
#pragma unroll
                        for (int e = 0; e < 4; ++e) { const float lo = __uint_as_float(w[e] << 16), hi = __uint_as_float(w[e] & 0xffff0000u); q += lo * lo + hi * hi; } } }
                if (NORM) { q += __shfl_xor(q, 16); q += __shfl_xor(q, 32); if (fq == 0) ss[(size_t)(u.pm * BM + r) * 16 + u.pn * 4 + wc] = q; } }
    }
};
}

#define DI __device__ __forceinline__
typedef unsigned short bf16_t;
typedef short bf16x8 __attribute__((ext_vector_type(8)));
typedef float f32x16 __attribute__((ext_vector_type(16)));
typedef float f32x4 __attribute__((ext_vector_type(4)));
typedef unsigned u32x4 __attribute__((ext_vector_type(4)));
typedef unsigned u32x2 __attribute__((ext_vector_type(2)));
#define MFMA32(a, b, c) __builtin_amdgcn_mfma_f32_32x32x16_bf16((a), (b), (c), 0, 0, 0)
constexpr int T_ = 32768, S_ = 8192, NBAT = 4, DM = 1024, FF = 4096;
constexpr int LDP0 = 2048, LDP1 = 2304;
constexpr float LOG2E = 1.4426950408889634f, LN2 = 0.6931471805599453f;
constexpr float C1 = 0.125f * LOG2E;
constexpr float RMS_EPS = 1e-6f;
constexpr size_t MiB = 1024 * 1024;
constexpr size_t WS_W0QK = 0, WS_W0V = 4 * MiB, WS_W0O = 6 * MiB, WS_W1A = 8 * MiB, WS_W1V = 8 * MiB + 4608 * 1024, WS_W1O = WS_W1V + 1 * MiB,
                 WS_WM1 = WS_W1O + 2 * MiB, WS_WM2 = WS_WM1 + 16 * MiB, WS_WC1 = WS_WM2 + 16 * MiB, WS_WC2 = WS_WC1 + 2 * MiB, WS_BIAS = WS_WC2 + 64 * 1024,
                 WS_KC = 50 * MiB, WS_VCT = 51 * MiB, WS_XN = 52 * MiB, WS_BIG = 116 * MiB, WS_VT = WS_BIG + 160 * MiB, WS_XB = WS_BIG + 256 * MiB, WS_SS = WS_XB + 64 * MiB, WS_RS = WS_SS + 2 * MiB, WS_KSF = WS_RS + 1 * MiB, WS_END = WS_KSF + 16 * MiB;
static_assert(WS_BIAS + 4096 <= 50 * MiB - 20480, "ws map");
constexpr int LDS_GEMM = 131072;
constexpr int LDS_BYTES = LDS_GEMM + 16;
constexpr size_t WS_BAR = 50 * MiB - 16384;
constexpr size_t WS_QCTR = WS_BAR + 13824;
constexpr size_t WS_KMX = 50 * MiB - 20480;
constexpr int WAVE_LDS = 8704;

struct Params { const float* in[21]; float* out; unsigned char* ws; int ph_lo, ph_hi; };

DI unsigned pk2(float a, float b) { return pg8::pkbf(a, b); }
DI bf16x8 ldg8(const bf16_t* p) { return *(const bf16x8*)p; }
DI float fexp2(float x) { return __builtin_amdgcn_exp2f(x); }
DI float flog2(float x) { return __builtin_amdgcn_logf(x); }
DI float bf2f(bf16_t v) { return __uint_as_float((unsigned)v << 16); }
DI bf16x8 pack8(float a0, float a1, float a2, float a3, float a4, float a5, float a6, float a7) {
    u32x4 p; p.x = pk2(a0, a1); p.y = pk2(a2, a3); p.z = pk2(a4, a5); p.w = pk2(a6, a7); return __builtin_bit_cast(bf16x8, p); }
DI void wave_lds_sync() { asm volatile("s_waitcnt lgkmcnt(0)" ::: "memory"); }
DI float wave_sum(float v) {
#pragma unroll
    for (int o = 1; o < 64; o <<= 1) v += __shfl_xor(v, o);
    return v; }
DI f32x16 zero16() { f32x16 z;
#pragma unroll
    for (int i = 0; i < 16; ++i) z[i] = 0.f;
    return z; }
DI int vfrag_off(int d, int ch) { return ((((d >> 5) * 2 + (ch >> 1)) * 2 + (ch & 1)) * 32 + (d & 31)) * 8; }
DI int krow_of(int r) { return 16 * (r >> 4) + 8 * ((r >> 2) & 1) + 4 * ((r >> 3) & 1) + (r & 3); }

DI void transpose_item(const float* W, int K, int N, int c0, int nc, bf16_t* WT, int r0, int item, float* scr, int lane, const float* gain, bool frag) {
    const int nblk = nc >> 5, kb = item / nblk, nb = item - kb * nblk, k0 = 64 * kb, n0 = 32 * nb;
    const int col = c0 + n0 + (lane & 31); const bool ok = col < N;
    const float* src = W + (size_t)(k0 + (lane >> 5)) * N + (ok ? col : c0);
    float v[32];
#pragma unroll
    for (int i = 0; i < 32; ++i) v[i] = src[(size_t)(2 * i) * N];
    if (gain) {
        float gv[32];
#pragma unroll
        for (int i = 0; i < 32; ++i) gv[i] = gain[k0 + 2 * i + (lane >> 5)];
#pragma unroll
        for (int i = 0; i < 32; ++i) v[i] *= gv[i];
    }
#pragma unroll
    for (int i = 0; i < 32; ++i) scr[(2 * i + (lane >> 5)) * 33 + (lane & 31)] = ok ? v[i] : 0.f;
    wave_lds_sync();
    const int c = lane & 7;
#pragma unroll
    for (int j = 0; j < 4; ++j) { const int n = (lane >> 3) + 8 * j; const float* s = scr + (8 * c) * 33 + n;
        u32x4 o; o.x = pk2(s[0 * 33], s[1 * 33]); o.y = pk2(s[2 * 33], s[3 * 33]); o.z = pk2(s[4 * 33], s[5 * 33]); o.w = pk2(s[6 * 33], s[7 * 33]);
        if (frag) { const int nn = r0 + n0 + n, k = k0 + 8 * c;
            *(u32x4*)(WT + ((size_t)((k >> 4) * 8 + (nn >> 5)) * 64 + ((k >> 3) & 1) * 32 + (nn & 31)) * 8) = o; }
        else *(u32x4*)(WT + (size_t)(r0 + n0 + n) * K + k0 + 8 * c) = o; }
    wave_lds_sync();
}
struct Seg { const float* W; int K, N, c0, nc, r0; bf16_t* dst; };
DI Seg get_seg(const Params& p, int s) {
    unsigned char* ws = p.ws; Seg g;
    switch (s) {
    case 0:  g = Seg{p.in[4], 1024, 3072, 0, 1024, 0, (bf16_t*)(ws + WS_W0QK)}; break;
    case 1:  g = Seg{p.in[4], 1024, 3072, 1536, 1024, 1024, (bf16_t*)(ws + WS_W0QK)}; break;
    case 2:  g = Seg{p.in[4], 1024, 3072, 1024, 512, 0, (bf16_t*)(ws + WS_W0V)}; break;
    case 3:  g = Seg{p.in[4], 1024, 3072, 2560, 512, 512, (bf16_t*)(ws + WS_W0V)}; break;
    case 4:  g = Seg{p.in[10], 1024, 1024, 0, 1024, 0, (bf16_t*)(ws + WS_W0O)}; break;
    case 5:  g = Seg{p.in[11], 1024, 2608, 0, 1536, 0, (bf16_t*)(ws + WS_W1A)}; break;
    case 6:  g = Seg{p.in[11], 1024, 2608, 1536, 256, 1536, (bf16_t*)(ws + WS_W1A)}; break;
    case 7:  g = Seg{p.in[11], 1024, 2608, 2048, 256, 1792, (bf16_t*)(ws + WS_W1A)}; break;
    case 8:  g = Seg{p.in[11], 1024, 2608, 2560, 256, 2048, (bf16_t*)(ws + WS_W1A)}; break;
    case 9:  g = Seg{p.in[11], 1024, 2608, 1792, 256, 0, (bf16_t*)(ws + WS_W1V)}; break;
    case 10: g = Seg{p.in[11], 1024, 2608, 2304, 256, 256, (bf16_t*)(ws + WS_W1V)}; break;
    case 11: g = Seg{p.in[18], 1024, 1024, 0, 1024, 0, (bf16_t*)(ws + WS_W1O)}; break;
    case 12: g = Seg{p.in[19], 1024, 4096, 0, 4096, 0, (bf16_t*)(ws + WS_WM1)}; break;
    case 13: g = Seg{p.in[19] + (size_t)1024 * 4096, 1024, 4096, 0, 4096, 0, (bf16_t*)(ws + WS_WM1 + 8 * MiB)}; break;
    case 14: g = Seg{p.in[20], 4096, 1024, 0, 1024, 0, (bf16_t*)(ws + WS_WM2)}; break;
    case 15: g = Seg{p.in[20] + (size_t)1024 * 4096, 4096, 1024, 0, 1024, 0, (bf16_t*)(ws + WS_WM2 + 8 * MiB)}; break;
    case 16: g = Seg{p.in[13], 2048, 256, 0, 256, 0, (bf16_t*)(ws + WS_WC1)}; break;
    case 17: g = Seg{p.in[16], 2048, 256, 0, 256, 0, (bf16_t*)(ws + WS_WC1 + 1 * MiB)}; break;
    case 18: g = Seg{p.in[14], 256, 64, 0, 64, 0, (bf16_t*)(ws + WS_WC2)}; break;
    default: g = Seg{p.in[17], 256, 64, 0, 64, 0, (bf16_t*)(ws + WS_WC2 + 32 * 1024)}; break;
    }
    return g;
}
constexpr int NSEG = 20;
DI void rms_rows(const float* X, const float* g, bf16_t* obf, float* of32, int gw, int ngw, int lane) {
    f32x4 gv[4];
#pragma unroll
    for (int j = 0; j < 4; ++j) gv[j] = ((const f32x4*)g)[lane + 64 * j];
    for (int row = gw * 2; row < T_; row += ngw * 2) {
        const f32x4* xr = (const f32x4*)(X + (size_t)row * DM) + lane;
        f32x4 v[2][4]; float rstd[2];
#pragma unroll
        for (int q = 0; q < 2; ++q)
#pragma unroll
            for (int j = 0; j < 4; ++j) v[q][j] = xr[q * 256 + 64 * j];
#pragma unroll
        for (int q = 0; q < 2; ++q) { float ss = 0.f;
#pragma unroll
            for (int j = 0; j < 4; ++j) ss += (v[q][j].x * v[q][j].x + v[q][j].y * v[q][j].y) + (v[q][j].z * v[q][j].z + v[q][j].w * v[q][j].w);
            rstd[q] = rsqrtf(wave_sum(ss) * (1.f / DM) + RMS_EPS); }
#pragma unroll
        for (int q = 0; q < 2; ++q)
#pragma unroll
            for (int j = 0; j < 4; ++j) {
                const f32x4 y = v[q][j] * rstd[q] * gv[j];
                if (obf) { u32x2 w; w.x = pk2(y.x, y.y); w.y = pk2(y.z, y.w); *((u32x2*)(obf + (size_t)(row + q) * DM) + lane + 64 * j) = w; }
                if (of32) ((f32x4*)(of32 + (size_t)(row + q) * DM))[lane + 64 * j] = y;
            }
    }
}
DI void final_rows(const bf16_t* X, const float* g, float* out, int gw, int ngw, int lane) {
    f32x4 gv[4];
#pragma unroll
    for (int j = 0; j < 4; ++j) gv[j] = ((const f32x4*)g)[lane + 64 * j];
    for (int row = gw * 4; row < T_; row += ngw * 4) {
        u32x2 bw[4][4]; float rstd[4];
#pragma unroll
        for (int q = 0; q < 4; ++q)
#pragma unroll
            for (int j = 0; j < 4; ++j) bw[q][j] = *((const u32x2*)(X + (size_t)(row + q) * DM) + lane + 64 * j);
#pragma unroll
        for (int q = 0; q < 4; ++q) { float ss = 0.f;
#pragma unroll
            for (int j = 0; j < 4; ++j) { const float a = __uint_as_float(bw[q][j].x << 16), b = __uint_as_float(bw[q][j].x & 0xffff0000u), c = __uint_as_float(bw[q][j].y << 16), d = __uint_as_float(bw[q][j].y & 0xffff0000u);
                ss += (a * a + b * b) + (c * c + d * d); }
            rstd[q] = rsqrtf(wave_sum(ss) * (1.f / DM) + RMS_EPS); }
#pragma unroll
        for (int q = 0; q < 4; ++q)
#pragma unroll
            for (int j = 0; j < 4; ++j) { f32x4 v; v.x = __uint_as_float(bw[q][j].x << 16); v.y = __uint_as_float(bw[q][j].x & 0xffff0000u); v.z = __uint_as_float(bw[q][j].y << 16); v.w = __uint_as_float(bw[q][j].y & 0xffff0000u);
                ((f32x4*)(out + (size_t)(row + q) * DM))[lane + 64 * j] = v * rstd[q] * gv[j]; }
    }
}
DI void phase_prologue(const Params& p, unsigned char* lds, int wave, int lane) {
    const int gw = blockIdx.x * 8 + wave, ngw = gridDim.x * 8;
    float* scr = (float*)(lds + wave * WAVE_LDS);
    int base = 0;
    for (int s = 0; s < NSEG; ++s) {
        const Seg g = get_seg(p, s);
        const int nit = (g.K >> 6) * (g.nc >> 5);
        int first = (gw - (base % ngw) + ngw) % ngw;
        for (int it = first; it < nit; it += ngw) transpose_item(g.W, g.K, g.N, g.c0, g.nc, g.dst, g.r0, it, scr, lane, s <= 3 ? p.in[1] : (s >= 5 && s <= 10) ? p.in[1] + DM : s == 12 ? p.in[2] : s == 13 ? p.in[2] + DM : nullptr, s == 16 || s == 17);
        base += nit;
    }
    if (blockIdx.x == 0 && wave == 0) { ((unsigned*)(p.ws + WS_KMX))[lane] = 0u; ((unsigned*)(p.ws + WS_KMX))[64 + lane] = 0u; }
    {
        bf16_t* XB = (bf16_t*)(p.ws + WS_XB); float* RSt = (float*)(p.ws + WS_RS);
        for (int row = gw * 4; row < T_; row += ngw * 4) {
            const f32x4* xr = (const f32x4*)(p.in[0] + (size_t)row * DM) + lane; f32x4 v[4][4]; float ss[4];
#pragma unroll
            for (int q = 0; q < 4; ++q)
#pragma unroll
                for (int j = 0; j < 4; ++j) v[q][j] = xr[q * 256 + 64 * j];
#pragma unroll
            for (int q = 0; q < 4; ++q) { float a = 0.f;
#pragma unroll
                for (int j = 0; j < 4; ++j) a += (v[q][j].x * v[q][j].x + v[q][j].y * v[q][j].y) + (v[q][j].z * v[q][j].z + v[q][j].w * v[q][j].w);
                ss[q] = wave_sum(a); }
#pragma unroll
            for (int q = 0; q < 4; ++q) {
#pragma unroll
                for (int j = 0; j < 4; ++j) { u32x2 w; w.x = pk2(v[q][j].x, v[q][j].y); w.y = pk2(v[q][j].z, v[q][j].w); *((u32x2*)(XB + (size_t)(row + q) * DM) + lane + 64 * j) = w; }
                if (lane == 0) RSt[row + q] = rsqrtf(ss[q] * (1.f / DM) + RMS_EPS); }
        }
    }
    for (int ob = gw; ob < 512; ob += ngw) {
        const int kv = ob >> 8, j = ob & 255; const float* pos = kv ? p.in[15] : p.in[12]; const float* w1 = kv ? p.in[16] : p.in[13];
        float a = 0.f;
        for (int i = 0; i < 32; ++i) { const int k = lane + 64 * i; a += pos[k] * w1[(size_t)k * 256 + j]; }
        a = wave_sum(a);
        if (lane == 0) ((float*)(p.ws + WS_BIAS))[ob] = a;
    }
}

DI void softmax_tile(f32x16& s, float& m, float& l, float& alpha) {
    float mt = fmaxf(fmaxf(s[0], s[1]), fmaxf(s[2], s[3]));
#pragma unroll
    for (int j = 4; j < 16; j += 4) mt = fmaxf(mt, fmaxf(fmaxf(s[j], s[j + 1]), fmaxf(s[j + 2], s[j + 3])));
    mt = fmaxf(mt, __shfl_xor(mt, 32));
    const float mn = fmaxf(m, mt); alpha = fexp2(m - mn); m = mn;
    float sum = 0.f;
#pragma unroll
    for (int j = 0; j < 16; ++j) { s[j] = fexp2(s[j] - mn); sum += s[j]; }
    l = l * alpha + sum;
}
DI bool soft_core(f32x16& s, float base, float slope2, bool boundary, int tmk8, int wlim, float& mref, bool& seen, float& l, float& alpha) {
    const float b0 = base - mref;
#pragma unroll
    for (int j = 0; j < 16; ++j) s[j] = fmaf(s[j], C1, fmaf(slope2, (float)(16 * (j >> 3) + (j & 7)), b0));
    if (boundary) {
#pragma unroll
        for (int j = 0; j < 16; ++j) { const int d = tmk8 - (16 * (j >> 3) + (j & 7)); s[j] = (d >= 0 && d < wlim) ? s[j] : -INFINITY; }
    }
    float mt = fmaxf(fmaxf(s[0], s[1]), fmaxf(s[2], s[3]));
#pragma unroll
    for (int j = 4; j < 16; j += 4) mt = fmaxf(mt, fmaxf(fmaxf(s[j], s[j + 1]), fmaxf(s[j + 2], s[j + 3])));
    mt = fmaxf(mt, __shfl_xor(mt, 32));
    const bool valid = mt > -1e30f, rebase = (mt > 8.f) || (!seen && valid);
    const bool any = __any(rebase);
    alpha = 1.f;
    if (any) {
        const float delta = rebase ? mt : 0.f;
#pragma unroll
        for (int j = 0; j < 16; ++j) s[j] -= delta;
        alpha = seen ? fexp2(-delta) : 1.f; mref += delta; l *= alpha;
    }
    seen = seen || valid;
    float sum = 0.f;
#pragma unroll
    for (int j = 0; j < 16; ++j) { s[j] = fexp2(s[j]); sum += s[j]; }
    l += sum;
    return any;
}
DI void soft_tile64(const bf16_t* ktile, const bf16_t* vtile, const bf16x8 (&qf)[4], int tmk, int wlim, bool colok, bool boundary, float slope2,
                    int lane, int hf, float& m, bool& seen, float& l, f32x16& o0, f32x16& o1) {
    const bf16_t* kr = ktile + lane * 8; const bf16_t* vr = vtile + lane * 8;
    f32x16 s = zero16();
#pragma unroll
    for (int ks = 0; ks < 4; ++ks) s = MFMA32(ldg8(kr + ks * 512), qf[ks], s);
    const bf16x8 va = ldg8(vr), vc = ldg8(vr + 512), vb = ldg8(vr + 1024), vd = ldg8(vr + 1536);
    float alpha;
    if (soft_core(s, colok ? -slope2 * (float)(tmk - 8 * hf) : -INFINITY, slope2, boundary, tmk - 8 * hf, wlim, m, seen, l, alpha)) { o0 *= alpha; o1 *= alpha; }
    const bf16x8 p0 = pack8(s[0], s[1], s[2], s[3], s[4], s[5], s[6], s[7]), p1 = pack8(s[8], s[9], s[10], s[11], s[12], s[13], s[14], s[15]);
    o0 = MFMA32(va, p0, o0); o1 = MFMA32(vb, p0, o1);
    o0 = MFMA32(vc, p1, o0); o1 = MFMA32(vd, p1, o1);
}
DI void store_o64(bf16_t* orow, const f32x16& o0, const f32x16& o1, int hf) {
#pragma unroll
    for (int q = 0; q < 4; ++q) {
        u32x2 w; w.x = pk2(o0[4 * q], o0[4 * q + 1]); w.y = pk2(o0[4 * q + 2], o0[4 * q + 3]); *(u32x2*)(orow + 8 * q + 4 * hf) = w;
        u32x2 x; x.x = pk2(o1[4 * q], o1[4 * q + 1]); x.y = pk2(o1[4 * q + 2], o1[4 * q + 3]); *(u32x2*)(orow + 32 + 8 * q + 4 * hf) = x;
    }
}

DI void sb_wave(const bf16_t* QK, const bf16_t* VT, bf16_t* O, int b, int h, int tq0, int lane) {
    const int r = lane & 31, hf = lane >> 5, krow = krow_of(r), t = tq0 + r;
    const bf16_t* qp = QK + (size_t)(b * S_ + t) * LDP0 + h * 64 + 8 * hf;
    bf16x8 qf[4];
#pragma unroll
    for (int ks = 0; ks < 4; ++ks) qf[ks] = ldg8(qp + 16 * ks);
    f32x16 o0 = zero16(), o1 = zero16();
    float R = 0.f;
    for (int kb = tq0; kb >= 0; kb -= 32) {
        const bf16_t* kr = QK + (size_t)(b * S_ + kb + krow) * LDP0 + 512 + h * 64 + 8 * hf;
        f32x16 s = zero16();
#pragma unroll
        for (int ks = 0; ks < 4; ++ks) s = MFMA32(ldg8(kr + 16 * ks), qf[ks], s);
        const int tmk = t - kb;
        f32x16 lr;
        float sumLo = 0.f, sumHi = 0.f;
#pragma unroll
        for (int j = 0; j < 16; ++j) {
            const float z = s[j] * 0.125f;
            const bool valid = (tmk - (16 * (j >> 3) + 8 * hf + (j & 7))) > 0;
            const float sp = fmaxf(z, 0.f) + flog2(1.f + fexp2(-fabsf(z) * LOG2E)) * LN2;
            lr[j] = valid ? -sp : 0.f;
            s[j] = valid ? z - sp : -INFINITY;
            if (j < 8) sumLo += lr[j]; else sumHi += lr[j];
        }
        const float pLo = __shfl_xor(sumLo, 32), pHi = __shfl_xor(sumHi, 32);
        float run = R + (hf == 0 ? pHi : 0.f);
#pragma unroll
        for (int j = 15; j >= 8; --j) { const float tl = run; run += lr[j]; s[j] = fexp2((s[j] + tl) * LOG2E); }
        run = R + sumHi + pHi + (hf == 0 ? pLo : 0.f);
#pragma unroll
        for (int j = 7; j >= 0; --j) { const float tl = run; run += lr[j]; s[j] = fexp2((s[j] + tl) * LOG2E); }
        R += (sumLo + sumHi) + (pLo + pHi);
        const bf16x8 p0 = pack8(s[0], s[1], s[2], s[3], s[4], s[5], s[6], s[7]), p1 = pack8(s[8], s[9], s[10], s[11], s[12], s[13], s[14], s[15]);
        const bf16_t* vt_ = VT + ((size_t)h * 1024 + (size_t)((b * S_ + kb) >> 5)) * 2048 + lane * 8;
        o0 = MFMA32(ldg8(vt_), p0, o0); o1 = MFMA32(ldg8(vt_ + 1024), p0, o1);
        o0 = MFMA32(ldg8(vt_ + 512), p1, o0); o1 = MFMA32(ldg8(vt_ + 1536), p1, o1);
        if (__all(R < -110.f)) break;
    }
    store_o64(O + (size_t)(b * S_ + t) * DM + h * 64, o0, o1, hf);
}

constexpr int DF_KB = 32 * 144, DF_VOFF = 2 * DF_KB, DF_BUF = DF_VOFF + 128 * 80, DF_STEP = 2 * DF_BUF  , DF_FLAGS = 2 * DF_STEP, DF_QIDX = DF_FLAGS + 64, DF_X = 0  ;
DI void diff_block(const bf16_t* QK, const bf16_t* VT, bf16_t* O, const float* subln, const unsigned* kmx, float lam, int b, int h, int tqb, int wave, int lane, unsigned char* lds) {
    const int tid = wave * 64 + lane, qs = wave & 3, c = wave >> 2;
    const int r = lane & 31, hf = lane >> 5, krow = krow_of(r), tq0 = tqb + 32 * qs, t = tq0 + r;
    const float slope2 = exp2f(-2.0f * (float)(h + 1)) * LOG2E;
    const int kc_ = tid >> 8, kkey = (tid >> 3) & 31, kch = tid & 7;
    const bf16_t* kg = QK + (size_t)(b * S_ + kkey) * LDP0 + 1536 + (h * 2 + kc_) * 64 + kch * 8;
    const int klds = kc_ * DF_KB + kkey * 144 + kch * 16;
    const int vd = tid >> 2, vch = tid & 3;
    const bf16_t* vg = VT + ((size_t)(8 + 2 * h + (vd >> 6)) * 1024 + (size_t)(b * S_ >> 5)) * 2048 + vfrag_off(vd & 63, vch);
    const int vlds = DF_VOFF + vd * 80 + vch * 16;
    const int kfo = c * DF_KB + krow * 144 + hf * 16, vfo = DF_VOFF + r * 80 + hf * 16;
    bf16x8 qf[4];
#pragma unroll
    for (int ks = 0; ks < 4; ++ks) qf[ks] = ldg8(QK + (size_t)(b * S_ + t) * LDP0 + 1024 + (h * 2 + c) * 64 + 8 * hf + 16 * ks);
    f32x16 o[4];
#pragma unroll
    for (int dt = 0; dt < 4; ++dt) o[dt] = zero16();
    float m = 0.f, l = 0.f; bool seen = false;
    float ub; { float qq = 0.f;
#pragma unroll
        for (int ks = 0; ks < 4; ++ks)
#pragma unroll
            for (int e = 0; e < 8; ++e) { const float v = bf2f((bf16_t)qf[ks][e]); qq += v * v; }
        qq += __shfl_xor(qq, 32);
        const float k2 = __uint_as_float(__hip_atomic_load(kmx + b * 16 + (h * 2 + c) * 2, __ATOMIC_RELAXED, __HIP_MEMORY_SCOPE_AGENT)) + __uint_as_float(__hip_atomic_load(kmx + b * 16 + (h * 2 + c) * 2 + 1, __ATOMIC_RELAXED, __HIP_MEMORY_SCOPE_AGENT));
        ub = sqrtf(qq * k2 * 1.02f) * C1; }
    volatile unsigned* flags = (volatile unsigned*)(lds + DF_FLAGS);
    int kb = tqb + 64; int itn = 0;
    u32x4 kreg[2], vreg[2];
#pragma unroll
    for (int j = 0; j < 2; ++j) { kreg[j] = *(const u32x4*)(kg + (size_t)(kb + 32 * j) * LDP0); vreg[j] = *(const u32x4*)(vg + (size_t)((kb + 32 * j) >> 5) * 2048); }
#pragma unroll
    for (int j = 0; j < 2; ++j) { *(u32x4*)(lds + j * DF_BUF + klds) = kreg[j]; *(u32x4*)(lds + j * DF_BUF + vlds) = vreg[j]; }
    __syncthreads();
    int cur = 0;
#pragma unroll 1
    for (; kb >= 0; kb -= 64) {
        const bool more = kb > 0;
        if (more) {
#pragma unroll
            for (int j = 0; j < 2; ++j) { kreg[j] = *(const u32x4*)(kg + (size_t)(kb - 64 + 32 * j) * LDP0); vreg[j] = *(const u32x4*)(vg + (size_t)((kb - 64 + 32 * j) >> 5) * 2048); } }
        const unsigned char* B0 = lds + cur * DF_STEP; const unsigned char* B1 = B0 + DF_BUF;
        const bool a0 = kb <= tq0, a1 = kb + 32 <= tq0;
        if (a0) {
            f32x16 s1 = zero16(), s0 = zero16();
            if (a1) {
#pragma unroll
                for (int ks = 0; ks < 4; ++ks) s1 = MFMA32(*(const bf16x8*)(B1 + kfo + ks * 32), qf[ks], s1); }
#pragma unroll
            for (int ks = 0; ks < 4; ++ks) s0 = MFMA32(*(const bf16x8*)(B0 + kfo + ks * 32), qf[ks], s0);
            float alpha;
            if (a1) {
                const int tmk = t - kb - 32;
                if (soft_core(s1, -slope2 * (float)(tmk - 8 * hf), slope2, kb + 32 == tq0, tmk - 8 * hf, 1 << 30, m, seen, l, alpha)) {
#pragma unroll
                    for (int dt = 0; dt < 4; ++dt) o[dt] *= alpha; }
                const bf16x8 p0 = pack8(s1[0], s1[1], s1[2], s1[3], s1[4], s1[5], s1[6], s1[7]), p1 = pack8(s1[8], s1[9], s1[10], s1[11], s1[12], s1[13], s1[14], s1[15]);
#pragma unroll
                for (int dt = 0; dt < 4; ++dt) { o[dt] = MFMA32(*(const bf16x8*)(B1 + vfo + dt * (32 * 80)), p0, o[dt]); o[dt] = MFMA32(*(const bf16x8*)(B1 + vfo + dt * (32 * 80) + 32), p1, o[dt]); }
            }
            {
                const int tmk = t - kb;
                if (soft_core(s0, -slope2 * (float)(tmk - 8 * hf), slope2, kb == tq0, tmk - 8 * hf, 1 << 30, m, seen, l, alpha)) {
#pragma unroll
                    for (int dt = 0; dt < 4; ++dt) o[dt] *= alpha; }
                const bf16x8 p0 = pack8(s0[0], s0[1], s0[2], s0[3], s0[4], s0[5], s0[6], s0[7]), p1 = pack8(s0[8], s0[9], s0[10], s0[11], s0[12], s0[13], s0[14], s0[15]);
#pragma unroll
                for (int dt = 0; dt < 4; ++dt) { o[dt] = MFMA32(*(const bf16x8*)(B0 + vfo + dt * (32 * 80)), p0, o[dt]); o[dt] = MFMA32(*(const bf16x8*)(B0 + vfo + dt * (32 * 80) + 32), p1, o[dt]); }
            }
        }
        if (more) { unsigned char* N = lds + (cur ^ 1) * DF_STEP;
#pragma unroll
            for (int j = 0; j < 2; ++j) { *(u32x4*)(N + j * DF_BUF + klds) = kreg[j]; *(u32x4*)(N + j * DF_BUF + vlds) = vreg[j]; } }
        { const bool mine = seen && (ub - slope2 * (float)(t - kb + 1) - m < -150.f);
          const bool dn = a0 && __all(mine);
          if (lane == 0) flags[(itn & 1) * 8 + wave] = dn ? 1u : 0u; }
        __syncthreads();
        cur ^= 1;
        { const volatile unsigned* f = flags + (itn & 1) * 8; const unsigned a = f[0] & f[1] & f[2] & f[3] & f[4] & f[5] & f[6] & f[7]; ++itn; if (a) break; }
    }
    l += __shfl_xor(l, 32);
    float* X = (float*)(lds + DF_X) + qs * 4096 + lane;
    if (c == 1) { const float i1 = lam / l;
#pragma unroll
        for (int dt = 0; dt < 4; ++dt)
#pragma unroll
            for (int j = 0; j < 16; ++j) X[(dt * 16 + j) * 64] = o[dt][j] * i1; }
    __syncthreads();
    if (c == 0) {
        const float i0 = 1.f / l; float ss = 0.f;
#pragma unroll
        for (int dt = 0; dt < 4; ++dt)
#pragma unroll
            for (int j = 0; j < 16; ++j) { const float v = o[dt][j] * i0 - X[(dt * 16 + j) * 64]; o[dt][j] = v; ss += v * v; }
        ss += __shfl_xor(ss, 32);
        const float rs = rsqrtf(ss * (1.f / 128.f) + RMS_EPS) * 0.8f;
        bf16_t* orow = O + (size_t)(b * S_ + t) * DM + 512 + h * 128;
#pragma unroll
        for (int dt = 0; dt < 4; ++dt)
#pragma unroll
            for (int q = 0; q < 4; ++q) { const int d = 32 * dt + 8 * q + 4 * hf; const f32x4 gsub = *(const f32x4*)(subln + d);
                u32x2 w; w.x = pk2(o[dt][4 * q] * rs * gsub.x, o[dt][4 * q + 1] * rs * gsub.y); w.y = pk2(o[dt][4 * q + 2] * rs * gsub.z, o[dt][4 * q + 3] * rs * gsub.w);
                *(u32x2*)(orow + d) = w; }
    }
}
DI void phase_attn0(const Params& p, unsigned char* lds, int wave, int lane, int rep = 0) {
    const bf16_t* QK = (const bf16_t*)(p.ws + WS_BIG); const bf16_t* VT = (const bf16_t*)(p.ws + WS_VT); bf16_t* O = (bf16_t*)(p.ws + WS_XN);
    const float d1 = wave_sum(p.in[5][lane] * p.in[6][lane]), d2 = wave_sum(p.in[7][lane] * p.in[8][lane]);
    const float lam = expf(d1) - expf(d2) + 0.2f;
    {
        unsigned* qctr = (unsigned*)(p.ws + WS_QCTR) + rep;
        volatile unsigned* qidx = (volatile unsigned*)(lds + DF_QIDX);
        for (;;) {
            if (threadIdx.x == 0) qidx[0] = atomicAdd(qctr, 1u);
            __syncthreads();
            const unsigned idx = qidx[0];
            __syncthreads();
            if (idx >= 1024u) break;
            const int bh = idx & 15, qt = 63 - (int)(idx >> 4);
            diff_block(QK, VT, O, p.in[9], (const unsigned*)(p.ws + WS_KMX), lam, bh >> 2, bh & 3, qt * 128, wave, lane, lds);
        }
    }
#pragma nounroll
    for (int rep = 0; rep < (PROBE_DUP == 22 ? 2 : 1); ++rep)
    for (int idx = blockIdx.x; idx < 1024; idx += gridDim.x) {
        const int bh = idx >> 5, qt = idx & 31;
        sb_wave(QK, VT, O, bh >> 3, bh & 7, qt * 256 + wave * 32, lane);
    }
}

DI float gelu_tanh(float x) { const float u = 0.7978845608028654f * (x + 0.044715f * x * x * x); const float e = fexp2(2.f * LOG2E * u); return 0.5f * x * (2.f - 2.f / (e + 1.f)); }
DI void phase_compress(const Params& p, unsigned char* lds, int wave, int lane) {
    const bf16_t* P1 = (const bf16_t*)(p.ws + WS_BIG);
    bf16_t* H = (bf16_t*)lds;
    const int r = lane & 31, hf = lane >> 5;
    for (int u = blockIdx.x; u < 512; u += gridDim.x) {
        const int kv = u >> 8, b = (u >> 6) & 3, g = (u >> 4) & 3, it = u & 15, i0 = 32 * it;
        const bf16_t* W1 = (const bf16_t*)(p.ws + WS_WC1 + (size_t)kv * MiB); const bf16_t* W2 = (const bf16_t*)(p.ws + WS_WC2 + (size_t)kv * 32 * 1024);
        const float* bias = (const float*)(p.ws + WS_BIAS) + kv * 256;
        unsigned char* AL = lds + 17408;
        { const bf16_t* src = P1 + (size_t)(b * S_) * LDP1 + 1024 + kv * 256 + g * 64;
          u32x4 tmp[9];
#pragma unroll
          for (int j = 0; j < 9; ++j) { const int c = min((int)threadIdx.x + 512 * j, 528 * 8 - 1), tl = c >> 3, ch = c & 7; const int tok = min(16 * i0 + tl, S_ - 1);
              tmp[j] = *(const u32x4*)(src + (size_t)tok * LDP1 + ch * 8); }
#pragma unroll
          for (int j = 0; j < 9; ++j) { const int c = (int)threadIdx.x + 512 * j, tl = c >> 3, ch = c & 7;
              if (c < 528 * 8) *(u32x4*)(AL + tl * 128 + (tl >> 7) * 128 + ((ch ^ ((tl >> 4) & 7)) << 4)) = tmp[j]; } }
        __syncthreads();
        const bf16_t* bp = W1 + (size_t)wave * 512 + lane * 8;
        f32x16 acc = zero16();
        bf16x8 rb[4][8];
#pragma unroll
        for (int gq = 0; gq < 4; ++gq)
#pragma unroll
            for (int u8 = 0; u8 < 8; ++u8) rb[gq][u8] = ldg8(bp + (size_t)(gq * 8 + u8) * 4096);
#pragma unroll 1
        for (int k0 = 0; k0 < 128; k0 += 32) {
#pragma unroll
            for (int gq = 0; gq < 4; ++gq) {
#pragma unroll
                for (int u8 = 0; u8 < 8; ++u8) { const int kk = k0 + gq * 8 + u8; const int tl = 16 * r + (kk >> 2), ch = 2 * (kk & 3) + hf;
                    acc = MFMA32(*(const bf16x8*)(AL + tl * 128 + (tl >> 7) * 128 + ((ch ^ ((tl >> 4) & 7)) << 4)), rb[gq][u8], acc); }
                if (k0 + 32 < 128) {
#pragma unroll
                    for (int u8 = 0; u8 < 8; ++u8) rb[gq][u8] = ldg8(bp + (size_t)(k0 + 32 + gq * 8 + u8) * 4096); }
            }
        }
        const float bj = bias[32 * wave + r];
#pragma unroll
        for (int j = 0; j < 16; ++j) { const int row = (j & 3) + 8 * (j >> 2) + 4 * hf; const float hval = gelu_tanh(acc[j] + bj);
            H[row * 264 + 32 * wave + r] = (bf16_t)(pk2(hval, 0.f) & 0xffffu); }
        __syncthreads();
        if (wave < 2) {
            f32x16 a2 = zero16();
            const bf16_t* hp = H + r * 264 + 8 * hf; const bf16_t* wp = W2 + (size_t)(32 * wave + r) * 256 + 8 * hf;
#pragma unroll
            for (int k2 = 0; k2 < 16; ++k2) a2 = MFMA32(*(const bf16x8*)(hp + 16 * k2), ldg8(wp + 16 * k2), a2);
            const int d = 32 * wave + r;
            if (kv == 0) {
                float mx = 0.f;
#pragma unroll
                for (int j = 0; j < 16; ++j) { float q = a2[j] * a2[j]; q += __shfl_xor(q, 1); q += __shfl_xor(q, 2); q += __shfl_xor(q, 4); q += __shfl_xor(q, 8); q += __shfl_xor(q, 16); mx = fmaxf(mx, q); }
                mx = fmaxf(mx, __shfl_xor(mx, 32));
                if (lane == 0) atomicMax((unsigned*)(p.ws + WS_KMX) + 96 + (b * 4 + g) * 2 + wave, __float_as_uint(mx)); }
            if (kv == 0) { bf16_t* kc = (bf16_t*)(p.ws + WS_KC) + (size_t)((b * 4 + g) * 512) * 64;
#pragma unroll
                for (int j = 0; j < 16; ++j) { const int i = i0 + (j & 3) + 8 * (j >> 2) + 4 * hf; kc[(size_t)i * 64 + d] = i < 511 ? (bf16_t)(pk2(a2[j], 0.f) & 0xffffu) : (bf16_t)0; }
            } else { bf16_t* vct = (bf16_t*)(p.ws + WS_VCT) + ((size_t)((b * 4 + g) * 16 + it) * 64 + d) * 32 - i0;
#pragma unroll
                for (int q = 0; q < 8; ++q) { const int j = (q >> 1) * 4 + (q & 1) * 2; const int i = i0 + (j & 3) + 8 * (j >> 2) + 4 * hf;
                    const float lo = a2[j], hi = (i + 1 < 511) ? a2[j + 1] : 0.f; *(unsigned*)(vct + i) = pk2(lo, hi); }
            }
        }
        __syncthreads();
    }
}

constexpr int NS_VOFF = 4608, NS_BUF = 9728, NS_BASE = 8 * WAVE_LDS;
DI f32x16 qk_lds(const unsigned char* B, const bf16x8 (&qf)[4], int krow, int hf) {
    f32x16 s = zero16();
#pragma unroll
    for (int ks = 0; ks < 4; ++ks) s = MFMA32(*(const bf16x8*)(B + krow * 144 + hf * 16 + ks * 32), qf[ks], s);
    return s; }
DI void pv_lds(const unsigned char* B, const bf16x8& p0, const bf16x8& p1, f32x16& o0, f32x16& o1, int r, int hf) {
    const unsigned char* v = B + NS_VOFF + r * 80 + hf * 16;
    o0 = MFMA32(*(const bf16x8*)(v), p0, o0); o1 = MFMA32(*(const bf16x8*)(v + 32 * 80), p0, o1);
    o0 = MFMA32(*(const bf16x8*)(v + 32), p1, o0); o1 = MFMA32(*(const bf16x8*)(v + 32 * 80 + 32), p1, o1); }
DI void nsa_block(const bf16_t* P1, const bf16_t* VT1, const bf16_t* KSF, const bf16_t* KC, const bf16_t* VCT, bf16_t* O, const unsigned* kmx, int b, int g, int t0b, int wave, int lane, unsigned char* lds) {
    unsigned char* wl = lds + wave * WAVE_LDS; unsigned char* SB = lds + NS_BASE;
    const int t0w = t0b + 8 * wave, tid = wave * 64 + lane;
    const bool kst = wave < 4;
    const int st_row = kst ? (tid >> 3) : ((tid - 256) >> 2), st_ch = kst ? (tid & 7) : ((tid - 256) & 3);
    const int st_dst = kst ? st_row * 144 + st_ch * 16 : NS_VOFF + st_row * 80 + st_ch * 16;
    u32x4 sreg = {0u, 0u, 0u, 0u};
    float* impA = (float*)wl; float* impB = impA + 1024; unsigned long long* selm = (unsigned long long*)(wl + 8192);
    const int r = lane & 31, hf = lane >> 5, tk = r >> 2, hh = r & 3, krow = krow_of(r);
    const int t = t0w + tk, head = g * 4 + hh, tmax = t0w + 7;
    const float slope2 = exp2f(-0.5f * (float)(head + 1)) * LOG2E;
    const bf16_t* prow = P1 + (size_t)(b * S_ + t) * LDP1;
    bf16x8 qf[4];
#pragma unroll
    for (int ks = 0; ks < 4; ++ks) qf[ks] = ldg8(prow + head * 64 + 8 * hf + 16 * ks);
    const float gc = 1.f / (1.f + __expf(-bf2f(prow[2048 + head * 3 + 0]))), gs = 1.f / (1.f + __expf(-bf2f(prow[2048 + head * 3 + 1]))), gwn = 1.f / (1.f + __expf(-bf2f(prow[2048 + head * 3 + 2])));
#pragma unroll
    for (int i = 0; i < 16; ++i) { impA[lane + 64 * i] = 0.f; impB[lane + 64 * i] = 0.f; }
    wave_lds_sync();
    const int nmax = tmax >= 31 ? ((tmax - 31) >> 4) + 1 : 0, ntile = (nmax + 31) >> 5;
    const bf16_t* kcb = KC + (size_t)((b * 4 + g) * 512) * 64;
    const bf16_t* vcb = VCT + (size_t)((b * 4 + g) * 64) * 512;
    int lo_b = 0, lo_w = 0;
    { float qq = 0.f;
#pragma unroll
      for (int ks = 0; ks < 4; ++ks)
#pragma unroll
          for (int e = 0; e < 8; ++e) { const float v = bf2f((bf16_t)qf[ks][e]); qq += v * v; }
      qq += __shfl_xor(qq, 32);
      const unsigned* kcm = kmx + 96 + (b * 4 + g) * 2;
      const float kc2 = __uint_as_float(__hip_atomic_load(kcm, __ATOMIC_RELAXED, __HIP_MEMORY_SCOPE_AGENT)) + __uint_as_float(__hip_atomic_load(kcm + 1, __ATOMIC_RELAXED, __HIP_MEMORY_SCOPE_AGENT));
      const float ubc = sqrtf(qq * kc2 * 1.02f) * C1;
      const float Dcol = (150.f + 2.f * ubc) / slope2 + 15.f;
      const float f = (((float)(t - 31) - Dcol) * (1.f / 16.f) - 31.f) * (1.f / 32.f);
      int lo = f > 0.f ? (int)floorf(f) : 0;
#pragma unroll
      for (int o = 1; o < 64; o <<= 1) lo = min(lo, __shfl_xor(lo, o));
      lo_w = lo;
      volatile int* xl = (volatile int*)(SB + 2 * NS_BUF + 64);
      if (lane == 0) xl[wave] = lo_w;
      __syncthreads();
      lo_b = min(min(min(xl[0], xl[1]), min(xl[2], xl[3])), min(min(xl[4], xl[5]), min(xl[6], xl[7]))); }
    float m = -1e30f, l = 0.f;
    const int tmaxb = t0b + 63, ntb = ((tmaxb >= 31 ? ((tmaxb - 31) >> 4) + 1 : 0) + 31) >> 5;
#define NS_CMP_SRC(n) (kst ? kcb + (size_t)(32 * (n) + st_row) * 64 + st_ch * 8 : vcb + (size_t)(n) * 2048 + st_row * 32 + st_ch * 8)
    if (ntb > lo_b) {
        if (kst) sreg = *(const u32x4*)NS_CMP_SRC(lo_b);
        if (kst) *(u32x4*)(SB + st_dst) = sreg;
        __syncthreads();
#pragma unroll 1
        for (int it = lo_b; it < ntb; ++it) {
            if (kst && it + 1 < ntb) sreg = *(const u32x4*)NS_CMP_SRC(it + 1);
            const unsigned char* B = SB + ((it - lo_b) & 1) * NS_BUF;
            if (it >= lo_w && it < ntile) {
                const int ib = 32 * it;
                f32x16 s = qk_lds(B, qf, krow, hf);
#pragma unroll
                for (int j = 0; j < 16; ++j) { const int dist = t - 31 - 16 * (ib + 16 * (j >> 3) + 8 * hf + (j & 7)); s[j] = dist >= 0 ? s[j] * C1 - slope2 * (float)dist : -INFINITY; }
                float alpha; softmax_tile(s, m, l, alpha);
            }
            if (kst && it + 1 < ntb) *(u32x4*)(SB + ((it + 1 - lo_b) & 1) * NS_BUF + st_dst) = sreg;
            __syncthreads();
        }
    }
    l += __shfl_xor(l, 32);
    const float inv = (t >= 31) ? 1.f / l : 0.f;
    f32x16 of0 = zero16(), of1 = zero16();
    if (ntb > lo_b) {
        sreg = *(const u32x4*)NS_CMP_SRC(lo_b);
        *(u32x4*)(SB + st_dst) = sreg;
        __syncthreads();
    }
#pragma unroll 1
    for (int it = lo_b; it < ntb; ++it) {
        if (it + 1 < ntb) sreg = *(const u32x4*)NS_CMP_SRC(it + 1);
        const unsigned char* B = SB + ((it - lo_b) & 1) * NS_BUF;
        if (it >= lo_w && it < ntile) {
        const int ib = 32 * it;
        f32x16 s = qk_lds(B, qf, krow, hf);
#pragma unroll
        for (int j = 0; j < 16; ++j) { const int dist = t - 31 - 16 * (ib + 16 * (j >> 3) + 8 * hf + (j & 7)); s[j] = dist >= 0 ? fexp2(s[j] * C1 - slope2 * (float)dist - m) * inv : 0.f; }
#pragma unroll
        for (int q = 0; q < 4; ++q) {
            float gsum = (s[4 * q] + s[4 * q + 1]) + (s[4 * q + 2] + s[4 * q + 3]), e = s[4 * q + 3];
            gsum += __shfl_xor(gsum, 1); gsum += __shfl_xor(gsum, 2); e += __shfl_xor(e, 1); e += __shfl_xor(e, 2);
            const int ssel = (ib >> 2) + 4 * (q >> 1) + 2 * hf + (q & 1);
            if (hh == 0) { impA[tk * 128 + ssel] = gsum; if (ssel + 1 < 128) impB[tk * 128 + ssel + 1] = e; }
        }
        const bf16x8 p0 = pack8(s[0], s[1], s[2], s[3], s[4], s[5], s[6], s[7]), p1 = pack8(s[8], s[9], s[10], s[11], s[12], s[13], s[14], s[15]);
        pv_lds(B, p0, p1, of0, of1, r, hf);
        }
        if (it + 1 < ntb) *(u32x4*)(SB + ((it + 1 - lo_b) & 1) * NS_BUF + st_dst) = sreg;
        __syncthreads();
    }
#undef NS_CMP_SRC
    of0 *= gc; of1 *= gc;
    wave_lds_sync();
    const unsigned long long lt_mask = (1ull << lane) - 1ull;
    for (int k2 = 0; k2 < 8; ++k2) {
        const int cur = (t0w + k2) >> 6;
        unsigned long long ma, mb;
        if (cur < 16) { ma = __ballot(lane <= cur); mb = 0ull; }
        else {
            const float va = impA[k2 * 128 + lane] + impB[k2 * 128 + lane], vb = impA[k2 * 128 + 64 + lane] + impB[k2 * 128 + 64 + lane];
            const int sa = lane, sb = lane + 64;
            const unsigned ka = (sa >= 1 && sa <= cur - 2) ? __float_as_uint(va) + 1u : 0u, kb = (sb <= cur - 2) ? __float_as_uint(vb) + 1u : 0u;
            unsigned tau = 0u;
            for (int bit = 31; bit >= 0; --bit) { const unsigned trial = tau | (1u << bit);
                const int cnt = __popcll(__ballot(ka >= trial)) + __popcll(__ballot(kb >= trial)); if (cnt >= 13) tau = trial; }
            const unsigned long long eqA = __ballot(ka == tau), eqB = __ballot(kb == tau);
            const int need = 13 - __popcll(__ballot(ka > tau)) - __popcll(__ballot(kb > tau));
            const int rankA = __popcll(eqA & lt_mask), rankB = __popcll(eqA) + __popcll(eqB & lt_mask);
            const bool selA = (ka > tau) || (ka == tau && rankA < need) || sa == 0 || sa == cur || sa == cur - 1;
            const bool selB = (kb > tau) || (kb == tau && rankB < need) || sb == cur || sb == cur - 1;
            ma = __ballot(selA); mb = __ballot(selB);
        }
        if (lane == 0) { selm[2 * k2] = ma; selm[2 * k2 + 1] = mb; }
    }
    wave_lds_sync();
    const unsigned long long mlo = selm[2 * tk], mhi = selm[2 * tk + 1];
    unsigned long long ulo = 0ull, uhi = 0ull;
#pragma unroll
    for (int k2 = 0; k2 < 8; ++k2) { ulo |= selm[2 * k2]; uhi |= selm[2 * k2 + 1]; }
    const bf16_t* ksb = KSF + ((size_t)g * 1024 + (size_t)(b * S_ >> 5)) * 2048; const bf16_t* vsb = VT1 + ((size_t)g * 1024 + (size_t)(b * S_ >> 5)) * 2048;
    const bf16_t* kwb = P1 + (size_t)(b * S_) * LDP1 + 1792 + g * 64; const bf16_t* vwb = VT1 + ((size_t)(4 + g) * 1024 + (size_t)(b * S_ >> 5)) * 2048;
    {
        f32x16 o0 = zero16(), o1 = zero16(); m = 0.f; l = 0.f; bool seen = false;
        float ubq; { float qq = 0.f;
#pragma unroll
            for (int ks = 0; ks < 4; ++ks)
#pragma unroll
                for (int e = 0; e < 8; ++e) { const float v = bf2f((bf16_t)qf[ks][e]); qq += v * v; }
            qq += __shfl_xor(qq, 32);
            const float k2 = __uint_as_float(__hip_atomic_load(kmx + 64 + b * 8 + 2 * g, __ATOMIC_RELAXED, __HIP_MEMORY_SCOPE_AGENT)) + __uint_as_float(__hip_atomic_load(kmx + 64 + b * 8 + 2 * g + 1, __ATOMIC_RELAXED, __HIP_MEMORY_SCOPE_AGENT));
            ubq = sqrtf(qq * k2 * 1.02f) * C1; }
        bool stop = false;
#pragma unroll 1
        for (int half = 1; half >= 0 && !stop; --half) {
            unsigned long long U = half ? uhi : ulo; const unsigned long long mine = half ? mhi : mlo;
            U = ((unsigned long long)__builtin_amdgcn_readfirstlane((unsigned)(U >> 32)) << 32) | (unsigned long long)__builtin_amdgcn_readfirstlane((unsigned)U);
            while (U) {
                const int bit = 63 - __builtin_clzll(U); U &= ~(1ull << bit);
                const bool colok = (mine >> bit) & 1ull;
                const int kb0 = (bit + 64 * half) * 64;
                if (__all(seen && (ubq - slope2 * (float)(t - (kb0 + 63)) - m < -150.f))) { stop = true; break; }
#pragma unroll 1
                for (int sub = 0; sub < 2; ++sub) { const int kb = kb0 + 32 * sub; if (kb > tmax) break;
                    soft_tile64(ksb + (size_t)(kb >> 5) * 2048, vsb + (size_t)(kb >> 5) * 2048, qf, t - kb, 1 << 30, colok, kb + 31 > t0w, slope2, lane, hf, m, seen, l, o0, o1); }
            }
        }
        l += __shfl_xor(l, 32);
        const float sc = gs / l; of0 += o0 * sc; of1 += o1 * sc;
    }
    {
        f32x16 o0 = zero16(), o1 = zero16(); m = 0.f; l = 0.f; bool seen = false;
        int lo = t0w - 511; if (lo < 0) lo = 0;
        const int kb_lo = lo & ~31, kb_hi = t0w & ~31;
        int lob = t0b - 511; if (lob < 0) lob = 0;
        const int kb_lob = lob & ~31, kb_hib = t0b + 32, nwt = ((kb_hib - kb_lob) >> 5) + 1;
#define NS_WIN_SRC(kb_) (kst ? kwb + (size_t)((kb_) + st_row) * LDP1 + st_ch * 8 : vwb + (size_t)((kb_) >> 5) * 2048 + vfrag_off(st_row, st_ch))
        sreg = *(const u32x4*)NS_WIN_SRC(kb_hib);
        *(u32x4*)(SB + st_dst) = sreg;
        __syncthreads();
#pragma unroll 1
        for (int n = 0; n < nwt; ++n) {
            const int kb = kb_hib - 32 * n;
            if (n + 1 < nwt) sreg = *(const u32x4*)NS_WIN_SRC(kb - 32);
            const unsigned char* B = SB + (n & 1) * NS_BUF;
            if (kb >= kb_lo && kb <= kb_hi) {
                f32x16 sc_ = qk_lds(B, qf, krow, hf);
                float alpha;
                if (soft_core(sc_, -slope2 * (float)(t - kb - 8 * hf), slope2, (kb + 31 > t0w) || (tmax - kb >= 512), t - kb - 8 * hf, 512, m, seen, l, alpha)) { o0 *= alpha; o1 *= alpha; }
                const bf16x8 p0 = pack8(sc_[0], sc_[1], sc_[2], sc_[3], sc_[4], sc_[5], sc_[6], sc_[7]), p1 = pack8(sc_[8], sc_[9], sc_[10], sc_[11], sc_[12], sc_[13], sc_[14], sc_[15]);
                pv_lds(B, p0, p1, o0, o1, r, hf);
            }
            if (n + 1 < nwt) *(u32x4*)(SB + ((n + 1) & 1) * NS_BUF + st_dst) = sreg;
            __syncthreads();
        }
#undef NS_WIN_SRC
        l += __shfl_xor(l, 32);
        const float sc = gwn / l; of0 += o0 * sc; of1 += o1 * sc;
    }
    store_o64(O + (size_t)(b * S_ + t) * DM + head * 64, of0, of1, hf);
}
DI void phase_nsa(const Params& p, unsigned char* lds, int wave, int lane, int rep = 0) {
    const bf16_t* P1 = (const bf16_t*)(p.ws + WS_BIG); const bf16_t* VT1 = (const bf16_t*)(p.ws + WS_VT);
    const bf16_t* KC = (const bf16_t*)(p.ws + WS_KC); const bf16_t* VCT = (const bf16_t*)(p.ws + WS_VCT); bf16_t* O = (bf16_t*)(p.ws + WS_XN);
    unsigned* qctr = (unsigned*)(p.ws + WS_QCTR) + 8 + rep;
    volatile unsigned* qidx = (volatile unsigned*)(lds + NS_BASE + 2 * NS_BUF);
    for (;;) {
        if (threadIdx.x == 0) qidx[0] = atomicAdd(qctr, 1u);
        __syncthreads();
        const unsigned idx = qidx[0];
        __syncthreads();
        if (idx >= 2048u) break;
        const int bg = idx & 15, tile = 127 - (int)(idx >> 4);
        nsa_block(P1, VT1, (const bf16_t*)(p.ws + WS_KSF), KC, VCT, O, (const unsigned*)(p.ws + WS_KMX), bg >> 2, bg & 3, tile * 64, wave, lane, lds);
    }
}

#define XB_TMO      128
#define XB_XCNT(j)  (256  + 64 * (j))
#define XB_XSUB(j)  (1280 + 64 * (j))
#define XB_XGEN(j)  (2304 + 64 * (j))
#define XB_TOP      3328
#define XB_TOPGEN   3392
#define XCD_BAR_WORDS 3456
#define XB_SPIN_CAP (1u << 18)
#define LAS __attribute__((address_space(3)))

__device__ __forceinline__ unsigned xb_ld(unsigned* p)              { return __hip_atomic_load(p, __ATOMIC_RELAXED, __HIP_MEMORY_SCOPE_AGENT); }
__device__ __forceinline__ unsigned xb_add(unsigned* p, unsigned v) { return __hip_atomic_fetch_add(p, v, __ATOMIC_RELAXED, __HIP_MEMORY_SCOPE_AGENT); }
__device__ __forceinline__ unsigned xb_xcc_id() { return (unsigned)__builtin_amdgcn_s_getreg((3 << 11) | 20) & 0xFu; }
#define XB_SPIN(cond, bar) do { unsigned _sp = 0; while (cond) { __builtin_amdgcn_s_sleep(1); \
    if ((++_sp & 255u) == 0u) { if (xb_ld(&(bar)[XB_TMO])) break; if (_sp > XB_SPIN_CAP) { atomicAdd(&(bar)[XB_TMO], 1u); break; } } } } while (0)

struct XcdBarrier {
    unsigned* bar; unsigned x;
    volatile LAS unsigned* st;
};

__device__ __forceinline__ XcdBarrier xcd_barrier_post(unsigned* bar, volatile LAS unsigned* st) {
    XcdBarrier b; b.bar = bar; b.x = xb_xcc_id(); b.st = st;
    if (threadIdx.x == 0) (void)xb_add(&bar[XB_XCNT(b.x)], 1u);
    return b;
}
__device__ __forceinline__ void xcd_barrier_complete(unsigned* bar, unsigned x, unsigned& nloc, unsigned& nx) {
    const unsigned G = gridDim.x * gridDim.y * gridDim.z;
    unsigned sum, cnt, mine, sp = 0u;
    for (;;) {
        sum = 0u; cnt = 0u; mine = 0u;
#pragma unroll
        for (unsigned j = 0; j < 16; ++j) { const unsigned c = xb_ld(&bar[XB_XCNT(j)]); sum += c; cnt += (c > 0u) ? 1u : 0u; mine = (j == x) ? c : mine; }
        if (sum == G) break;
        __builtin_amdgcn_s_sleep(1);
        if ((++sp & 255u) == 0u) { if (xb_ld(&bar[XB_TMO])) break; if (sp > XB_SPIN_CAP) { atomicAdd(&bar[XB_TMO], 1u); break; } }
    }
    nloc = mine > 0u ? mine : 1u; nx = cnt > 0u ? cnt : 1u;
}

__device__ __forceinline__ void xcd_barrier(const XcdBarrier& b) {
    asm volatile("s_waitcnt vmcnt(0)" ::: "memory");
    __syncthreads();
    if (threadIdx.x == 0) {
        unsigned* bar = b.bar;
        __builtin_amdgcn_s_waitcnt(0);
        unsigned nloc = b.st[0], nx = b.st[1];
        if (nloc == 0u) { xcd_barrier_complete(bar, b.x, nloc, nx); b.st[0] = nloc; b.st[1] = nx; }
        const unsigned old = xb_add(&bar[XB_XSUB(b.x)], 1u);
        const unsigned gen = old / nloc;
        if (old + 1u == (gen + 1u) * nloc) {
            __builtin_amdgcn_fence(__ATOMIC_RELEASE, "agent");
            asm volatile("s_waitcnt vmcnt(0)" ::: "memory");
            const unsigned og = xb_add(&bar[XB_TOP], 1u);
            const unsigned tg = og / nx;
            if (og + 1u == (tg + 1u) * nx) xb_add(&bar[XB_TOPGEN], 1u);
            else XB_SPIN(xb_ld(&bar[XB_TOPGEN]) == tg, bar);
            __builtin_amdgcn_fence(__ATOMIC_ACQUIRE, "agent");
            xb_add(&bar[XB_XGEN(b.x)], 1u);
            asm volatile("s_waitcnt vmcnt(0)" ::: "memory");
        } else {
            XB_SPIN(xb_ld(&bar[XB_XGEN(b.x)]) == gen, bar);
            __builtin_amdgcn_fence(__ATOMIC_ACQUIRE, "agent");
            asm volatile("s_waitcnt vmcnt(0)" ::: "memory");
        }
    }
    __syncthreads();
}

static_assert(XCD_BAR_WORDS * 4 == 13824, "queue counter sits right behind the barrier words");
DI void rs_for_units(int M, int N, bool by_col, const float* SS, float* RS) {
    pg8::StaticOrder S; S.init(M, N, (int)gridDim.x, (int)blockIdx.x);
    pg8::Unit u; int last = -1; const int tid = threadIdx.x;
    for (int i = 0; S.next(i, u); ++i) {
        const int panel = by_col ? u.pn : u.pm;
        if (panel == last) continue;
        last = panel;
        const int row = panel * 256 + (tid >> 1);
        const f32x4* pp = (const f32x4*)(SS + (size_t)row * 16 + (tid & 1) * 8);
        const f32x4 a = pp[0], b = pp[1];
        float v = ((a[0] + a[1]) + (a[2] + a[3])) + ((b[0] + b[1]) + (b[2] + b[3]));
        v += __shfl_xor(v, 1);
        if ((tid & 1) == 0) RS[row] = rsqrtf(v * (1.f / DM) + RMS_EPS);
    }
    asm volatile("s_waitcnt vmcnt(0)" ::: "memory");
    __syncthreads();
}
template <class Epi> DI void run_gemm(unsigned char* lds, const bf16_t* A, const bf16_t* Bt, int M, int N, int K, const Epi& E) {
    pg8::Gemm g{A, Bt, M, N, K}; pg8::StaticOrder S; S.init(M, N, (int)gridDim.x, (int)blockIdx.x);
    pg8::gemm_phase<Epi, pg8::StaticOrder, true, true>((PG8_LAS unsigned char*)lds, g, S, E);
}
#ifndef PROBE_DUP
#define PROBE_DUP 0
#endif
#ifndef ONLY_PHASE
#define ONLY_PHASE -1
#endif
#define PH_EN(n) (ONLY_PHASE < 0 || ONLY_PHASE == (n))
constexpr int NPHASE = 16;
__global__ void __launch_bounds__(512) trunk_fwd(Params p) {
    extern __shared__ __attribute__((aligned(16))) unsigned char lds[];
    cg::grid_group grid = cg::this_grid();
    const int tid = threadIdx.x, lane = tid & 63, wave = __builtin_amdgcn_readfirstlane(tid >> 6);
    const int gw = blockIdx.x * 8 + wave, ngw = gridDim.x * 8;
    unsigned char* ws = p.ws;
    bf16_t* XN = (bf16_t*)(ws + WS_XN); bf16_t* BIG = (bf16_t*)(ws + WS_BIG); bf16_t* VT = (bf16_t*)(ws + WS_VT);
    const int lo = p.ph_lo, hi = p.ph_hi;
    if (hi > 1000) grid.sync();
    if (tid < 4) ((unsigned*)(lds + LDS_GEMM))[tid] = 0u;
    __syncthreads();
    XcdBarrier xbar = xcd_barrier_post((unsigned*)(ws + WS_BAR), (volatile LAS unsigned*)(lds + LDS_GEMM));
#define IN(k) (PH_EN(k) && lo <= (k) && (k) < hi)
#define SEAM(k) do { if ((k) + 1 < hi) { _Pragma("nounroll") for (int rep_ = 0; rep_ < (PROBE_DUP == 99 ? 3 : 1); ++rep_) xcd_barrier(xbar); } } while (0)
    if (IN(0)) {
#pragma nounroll
        for (int rep = 0; rep < (PROBE_DUP == 100 ? 2 : 1); ++rep) phase_prologue(p, lds, wave, lane);
        SEAM(0); }
    bf16_t* XB = (bf16_t*)(ws + WS_XB); float* SS = (float*)(ws + WS_SS); float* RS = (float*)(ws + WS_RS);
#define RSTD_PASS() do { for (int r4 = gw * 4; r4 < T_; r4 += ngw * 4) { float v = SS[(size_t)r4 * 16 + lane]; v += __shfl_xor(v, 1); v += __shfl_xor(v, 2); v += __shfl_xor(v, 4); v += __shfl_xor(v, 8); if ((lane & 15) == 0) RS[r4 + (lane >> 4)] = rsqrtf(v * (1.f / DM) + RMS_EPS); } } while (0)
    if (IN(1)) { run_gemm(lds, XB, (const bf16_t*)(ws + WS_W0QK), T_, 2048, DM, pg8::EpiB<0, true, 1>{BIG, LDP0, (unsigned*)(ws + WS_KMX), 6, 8, RS, nullptr, -1});
                 run_gemm(lds, (const bf16_t*)(ws + WS_W0V), XB, 1024, T_, DM, pg8::EpiB<0, false, 2, true>{VT, T_, nullptr, 0, 0, RS, nullptr, -1}); SEAM(1); }
    if (IN(2)) {
#pragma nounroll
        for (int rep = 0; rep < (PROBE_DUP == 2 ? 2 : 1); ++rep) phase_attn0(p, lds, wave, lane, rep);
        SEAM(2); }
    if (IN(3)) { run_gemm(lds, XN, (const bf16_t*)(ws + WS_W0O), T_, DM, DM, pg8::EpiRb<true>{XB, DM, SS}); SEAM(3); }
    if (IN(5)) { rs_for_units(T_, FF, false, SS, RS);
                 run_gemm(lds, XB, (const bf16_t*)(ws + WS_WM1), T_, FF, DM, pg8::EpiB<1, false, 1>{BIG, FF, nullptr, 0, 0, RS, nullptr, -1}); SEAM(5); }
    if (IN(6)) { run_gemm(lds, BIG, (const bf16_t*)(ws + WS_WM2), T_, DM, FF, pg8::EpiRb<true>{XB, DM, SS}); SEAM(6); }
    if (IN(8)) { rs_for_units(T_, LDP1, false, SS, RS); rs_for_units(512, T_, true, SS, RS);
                 run_gemm(lds, XB, (const bf16_t*)(ws + WS_W1A), T_, LDP1, DM, pg8::EpiB<0, true, 1>{BIG, LDP1, (unsigned*)(ws + WS_KMX) + 64, 6, 7, RS, (bf16_t*)(ws + WS_KSF), 6});
                 run_gemm(lds, (const bf16_t*)(ws + WS_W1V), XB, 512, T_, DM, pg8::EpiB<0, false, 2, true>{VT, T_, nullptr, 0, 0, RS, nullptr, -1}); SEAM(8); }
    if (IN(9)) {
#pragma nounroll
        for (int rep = 0; rep < (PROBE_DUP == 9 ? 2 : 1); ++rep) phase_compress(p, lds, wave, lane);
        SEAM(9); }
    if (IN(10)) {
#pragma nounroll
        for (int rep = 0; rep < (PROBE_DUP == 10 ? 2 : 1); ++rep) phase_nsa(p, lds, wave, lane, rep);
        SEAM(10); }
    if (IN(11)) { run_gemm(lds, XN, (const bf16_t*)(ws + WS_W1O), T_, DM, DM, pg8::EpiRb<true>{XB, DM, SS}); SEAM(11); }
    if (IN(13)) { rs_for_units(T_, FF, false, SS, RS);
                  run_gemm(lds, XB, (const bf16_t*)(ws + WS_WM1 + 8 * MiB), T_, FF, DM, pg8::EpiB<1, false, 1>{BIG, FF, nullptr, 0, 0, RS, nullptr, -1}); SEAM(13); }
    if (IN(14)) { run_gemm(lds, BIG, (const bf16_t*)(ws + WS_WM2 + 8 * MiB), T_, DM, FF, pg8::EpiRb<false>{XB, DM, nullptr}); SEAM(14); }
    if (IN(15)) { final_rows(XB, p.in[3], p.out, gw, ngw, lane); }
#undef IN
#undef RSTD_PASS
#undef SEAM
}

#ifndef MK_PER_PHASE
#define MK_PER_PHASE 0
#endif
extern "C" void kernel_launch(void* const* d_in, const int* in_sizes, int n_in, void* d_out, int out_size, void* d_ws, size_t ws_size, hipStream_t stream) {
    static int grid = 0;
    if (grid == 0) {
        int dev = 0, cus = 0, per_cu = 0;
        (void)hipGetDevice(&dev);
        (void)hipDeviceGetAttribute(&cus, hipDeviceAttributeMultiprocessorCount, dev);
        if (hipFuncSetAttribute((const void*)trunk_fwd, hipFuncAttributeMaxDynamicSharedMemorySize, LDS_BYTES) != hipSuccess) fprintf(stderr, "kernel_launch: hipFuncSetAttribute failed\n");
        if (hipOccupancyMaxActiveBlocksPerMultiprocessor(&per_cu, (const void*)trunk_fwd, 512, LDS_BYTES) != hipSuccess || per_cu < 1) { fprintf(stderr, "kernel_launch: occupancy query says %d\n", per_cu); per_cu = 1; }
        (void)hipGetLastError();
        grid = cus * 1;
        if (n_in != 21 || ws_size < WS_END) fprintf(stderr, "kernel_launch: unexpected n_in %d / ws %zu\n", n_in, ws_size);
    }
    (void)hipMemsetAsync((unsigned char*)d_ws + WS_BAR, 0, (XCD_BAR_WORDS + 64) * sizeof(unsigned), stream);
    Params p{};
    for (int i = 0; i < 21; ++i) p.in[i] = (const float*)d_in[i];
    p.out = (float*)d_out; p.ws = (unsigned char*)d_ws;
#if MK_PER_PHASE
    for (int ph = 0; ph < NPHASE; ++ph) { p.ph_lo = ph; p.ph_hi = ph + 1; hipLaunchKernelGGL(trunk_fwd, dim3(grid), dim3(512), LDS_BYTES, stream, p); }
#else
    p.ph_lo = 0; p.ph_hi = NPHASE;
    void* args[] = {&p};
    hipError_t e = hipLaunchCooperativeKernel((const void*)trunk_fwd, dim3(grid), dim3(512), args, LDS_BYTES, stream);
    if (e != hipSuccess) fprintf(stderr, "kernel_launch: cooperative launch failed: %s (grid %d)\n", hipGetErrorString(e), grid);
#endif
}
```

```cpp
#define PROBE_DUP 0
#include <hip/hip_runtime.h>
#include <hip/hip_cooperative_groups.h>
#include <cstdio>
#include <cstdint>
namespace cg = cooperative_groups;
namespace pg8 {
#define PG8_LAS __attribute__((address_space(3)))
typedef unsigned short bf16_t;
typedef short bf16x8 __attribute__((ext_vector_type(8)));
typedef float f32x4 __attribute__((ext_vector_type(4)));
typedef unsigned u32x4 __attribute__((ext_vector_type(4)));
constexpr int BM = 256, BK = 64, HALF = 128, HTB = HALF * BK * 2  , STAGE_BYTES = 8 * HTB, NXCD = 8, WGM = 4;

__host__ __device__ __forceinline__ int lds_byte(int r, int c) { const int st = (r >> 4) * 2 + (c >> 5), rr = r & 15, cc = c & 31, ob = rr * 64 + cc * 2; return st * 1024 + (ob ^ (((ob >> 9) & 1) << 5)); }
__host__ __device__ __forceinline__ void stage_rc(int b, int& R, int& C) { const int st = b / 1024, sb = b % 1024, swz = sb ^ (((sb >> 9) & 1) << 5); R = (st >> 1) * 16 + swz / 64; C = (st & 1) * 32 + (swz % 64) / 2; }
__host__ __device__ __forceinline__ int perm32(int rho) { const int n = rho >> 4, i = rho & 15; return 8 * (i >> 2) + 4 * n + (i & 3); }

struct Unit { int pm, pn; };
struct Gemm { const bf16_t* A; const bf16_t* Bt; int M, N, K; };

struct StaticOrder {
    int nM, nN, nwg, G, c;
    __host__ __device__ void init(int M, int N, int G_, int c_) { nM = M / BM; nN = N / BM; nwg = nM * nN; G = G_; c = c_; }
    __host__ __device__ bool next(int i, Unit& u) const {
        const long L = (long)i * G + c; if (L >= nwg) return false;
        int wgid = (int)L; { const int q = nwg / NXCD, r = nwg % NXCD, xcd = wgid % NXCD, off = wgid / NXCD; wgid = (xcd < r ? xcd * (q + 1) : r * (q + 1) + (xcd - r) * q) + off; }
        const int nig = WGM * nN, gid = wgid / nig, fm = gid * WGM, gsz = (nM - fm) < WGM ? (nM - fm) : WGM;
        u.pm = fm + ((wgid % nig) % gsz); u.pn = (wgid % nig) / gsz; return true;
    }
    __device__ __forceinline__ void a_ready(const Unit&) const {}
    __device__ __forceinline__ void done(const Unit&) const {}
};

__device__ __forceinline__ unsigned cvt_pk_bf16(float lo, float hi) { unsigned r; asm volatile("v_cvt_pk_bf16_f32 %0, %1, %2" : "=v"(r) : "v"(lo), "v"(hi)); return r; }

template <class Epi, class Sched, bool ALIGN_EPI = false, bool SP2 = false>
__device__ __forceinline__ void gemm_phase(PG8_LAS unsigned char* lds, const Gemm g, const Sched& S, const Epi& E) {
    const int tid = threadIdx.x, wid = __builtin_amdgcn_readfirstlane(tid >> 6), lane = tid & 63, wr = wid >> 2, wc = wid & 3, fr = lane & 15, fq = lane >> 4;
    const int K = g.K, nt = K / BK;
    unsigned voffA[2], voffB[2];
#pragma unroll
    for (int i = 0; i < 2; ++i) { int R, C; stage_rc(tid * 16 + i * 8192, R, C); const int Rb = Epi::PERM ? ((R & ~31) + perm32(R & 31)) : R;
        voffA[i] = (unsigned)(R * K + C) * 2u; voffB[i] = (unsigned)(Rb * K + C) * 2u; }
    const size_t kstep = (size_t)(BK * 2);
    const size_t hstep = (size_t)HALF * K * 2;
    const size_t tstep = 2 * hstep;
    const unsigned ldsw = (unsigned)wid * 1024u;
    const int aoff = lds_byte(wr * 64 + fr, fq * 8), boff = lds_byte(wc * 32 + fr, fq * 8);
#define PG8_SA(b, h) (((b) * 2 + (h)) * HTB)
#define PG8_SB(b, h) ((4 + (b) * 2 + (h)) * HTB)
#define PG8_STAGE(bufoff, gbase, voff) do { _Pragma("unroll") for (int _i = 0; _i < 2; ++_i) \
        __builtin_amdgcn_global_load_lds((const unsigned*)((const char*)(gbase) + (voff)[_i]), (PG8_LAS unsigned*)(lds + (bufoff) + ldsw + _i * 8192), 16, 0, 0); } while (0)
#define PG8_LDA(dst, b, h) do { _Pragma("unroll") for (int m = 0; m < 4; ++m) _Pragma("unroll") for (int k = 0; k < 2; ++k) dst[m][k] = *(const PG8_LAS bf16x8*)(lds + PG8_SA(b, h) + aoff + m * 2048 + k * 1024); } while (0)
#define PG8_LDB(dst, b, h) do { _Pragma("unroll") for (int n = 0; n < 2; ++n) _Pragma("unroll") for (int k = 0; k < 2; ++k) dst[n][k] = *(const PG8_LAS bf16x8*)(lds + PG8_SB(b, h) + boff + n * 2048 + k * 1024); } while (0)
#define PG8_MMA(ai, bj, At, Bt) do { __builtin_amdgcn_s_setprio(1); _Pragma("unroll") for (int m = 0; m < 4; ++m) _Pragma("unroll") for (int n = 0; n < 2; ++n) _Pragma("unroll") for (int k = 0; k < 2; ++k) \
        acc[ai][bj][m][n] = __builtin_amdgcn_mfma_f32_16x16x32_bf16(Bt[n][k], At[m][k], acc[ai][bj][m][n], 0, 0, 0); __builtin_amdgcn_s_setprio(0); } while (0)
#define PG8_WAIT_V(n) asm volatile("s_waitcnt vmcnt(" #n ")" ::: "memory")
#define PG8_WAIT_L(n) asm volatile("s_waitcnt lgkmcnt(" #n ")" ::: "memory")
#define PG8_BAR __builtin_amdgcn_s_barrier()
#define PG8_SCHED __builtin_amdgcn_sched_barrier(0)
    Unit cur, nxt; int ui = 0;
    if (!S.next(0, cur)) return;
    f32x4 acc[2][2][4][2];
#pragma unroll
    for (int a = 0; a < 2; ++a)
#pragma unroll
        for (int b = 0; b < 2; ++b)
#pragma unroll
            for (int m = 0; m < 4; ++m)
#pragma unroll
                for (int n = 0; n < 2; ++n) acc[a][b][m][n] = (f32x4){0.f, 0.f, 0.f, 0.f};
    bf16x8 At[4][2], B0[2][2], B1[2][2];
    const char* cA = (const char*)g.A + (size_t)cur.pm * tstep; const char* cB = (const char*)g.Bt + (size_t)cur.pn * tstep;
    S.a_ready(cur);
    if constexpr (SP2) {
        PG8_STAGE(PG8_SB(0, 0), cB, voffB); PG8_STAGE(PG8_SB(0, 1), cB + hstep, voffB); PG8_STAGE(PG8_SA(0, 0), cA, voffA); PG8_STAGE(PG8_SA(0, 1), cA + hstep, voffA);
        if (wr == 1) PG8_BAR;
        PG8_WAIT_V(2); PG8_BAR;
        PG8_STAGE(PG8_SB(1, 0), cB + kstep, voffB); PG8_STAGE(PG8_SA(1, 0), cA + kstep, voffA); PG8_STAGE(PG8_SB(1, 1), cB + hstep + kstep, voffB);
        PG8_WAIT_V(6); PG8_BAR;
    } else {
        PG8_STAGE(PG8_SB(0, 0), cB, voffB); PG8_STAGE(PG8_SA(0, 0), cA, voffA); PG8_STAGE(PG8_SB(0, 1), cB + hstep, voffB); PG8_STAGE(PG8_SA(0, 1), cA + hstep, voffA);
        if (wr == 1) PG8_BAR;
        PG8_WAIT_V(4); PG8_BAR;
        PG8_STAGE(PG8_SB(1, 0), cB + kstep, voffB); PG8_STAGE(PG8_SA(1, 0), cA + kstep, voffA); PG8_STAGE(PG8_SB(1, 1), cB + hstep + kstep, voffB);
        PG8_WAIT_V(6); PG8_BAR;
    }
    for (;;) {
        const bool has_next = S.next(ui + 1, nxt);
        const char* nA = has_next ? (const char*)g.A + (size_t)nxt.pm * tstep : cA; const char* nB = has_next ? (const char*)g.Bt + (size_t)nxt.pn * tstep : cB;
        for (int t = 0; t < nt; t += 2) {
            const bool last = (t == nt - 2);
            const char* a1 = cA + (size_t)(t + 1) * kstep;
            const char* a2 = last ? nA : cA + (size_t)(t + 2) * kstep; const char* b2 = last ? nB : cB + (size_t)(t + 2) * kstep;
            const char* a3 = a2 + kstep; const char* b3 = b2 + kstep;
            if (last && has_next) S.a_ready(nxt);
            if constexpr (SP2) {
            PG8_LDB(B0, 0, 0); PG8_LDB(B1, 0, 1); PG8_SCHED; PG8_LDA(At, 0, 0); PG8_STAGE(PG8_SA(1, 1), a1 + hstep, voffA);
            PG8_WAIT_V(8); PG8_WAIT_L(0); PG8_BAR; PG8_MMA(0, 0, At, B0); PG8_MMA(0, 1, At, B1); PG8_BAR; PG8_SCHED;
            PG8_LDA(At, 0, 1); PG8_STAGE(PG8_SB(0, 0), b2, voffB); PG8_STAGE(PG8_SB(0, 1), b2 + hstep, voffB); PG8_STAGE(PG8_SA(0, 0), a2, voffA);
            PG8_WAIT_V(8); PG8_WAIT_L(0); PG8_BAR; PG8_MMA(1, 0, At, B0); PG8_MMA(1, 1, At, B1); PG8_BAR; PG8_SCHED;
            PG8_LDB(B0, 1, 0); PG8_LDB(B1, 1, 1); PG8_SCHED; PG8_LDA(At, 1, 0); PG8_STAGE(PG8_SA(0, 1), a2 + hstep, voffA);
            PG8_WAIT_V(8); PG8_WAIT_L(0); PG8_BAR; PG8_MMA(0, 0, At, B0); PG8_MMA(0, 1, At, B1); PG8_BAR; PG8_SCHED;
            PG8_LDA(At, 1, 1); PG8_STAGE(PG8_SB(1, 0), b3, voffB); PG8_STAGE(PG8_SB(1, 1), b3 + hstep, voffB); PG8_STAGE(PG8_SA(1, 0), a3, voffA);
            PG8_WAIT_V(8); PG8_WAIT_L(0); PG8_BAR; PG8_MMA(1, 0, At, B0); PG8_MMA(1, 1, At, B1); PG8_BAR; PG8_SCHED;
            } else {
            PG8_LDB(B0, 0, 0); PG8_SCHED; PG8_LDA(At, 0, 0); PG8_STAGE(PG8_SA(1, 1), a1 + hstep, voffA);
            PG8_WAIT_L(8); PG8_BAR; PG8_WAIT_L(0); PG8_MMA(0, 0, At, B0); PG8_BAR; PG8_SCHED;
            PG8_LDB(B1, 0, 1); PG8_STAGE(PG8_SB(0, 0), b2, voffB);
            PG8_BAR; PG8_WAIT_L(0); PG8_MMA(0, 1, At, B1); PG8_BAR;
            PG8_LDA(At, 0, 1); PG8_STAGE(PG8_SA(0, 0), a2, voffA);
            PG8_BAR; PG8_WAIT_L(0); PG8_MMA(1, 0, At, B0); PG8_BAR; PG8_SCHED;
            PG8_STAGE(PG8_SB(0, 1), b2 + hstep, voffB);
            PG8_WAIT_V(6); PG8_BAR; PG8_MMA(1, 1, At, B1); PG8_BAR;
            PG8_LDB(B0, 1, 0); PG8_SCHED; PG8_LDA(At, 1, 0); PG8_STAGE(PG8_SA(0, 1), a2 + hstep, voffA);
            PG8_WAIT_L(8); PG8_BAR; PG8_WAIT_L(0); PG8_MMA(0, 0, At, B0); PG8_BAR; PG8_SCHED;
            PG8_LDB(B1, 1, 1); PG8_STAGE(PG8_SB(1, 0), b3, voffB);
            PG8_BAR; PG8_WAIT_L(0); PG8_MMA(0, 1, At, B1); PG8_BAR;
            PG8_LDA(At, 1, 1); PG8_STAGE(PG8_SA(1, 0), a3, voffA);
            PG8_BAR; PG8_WAIT_L(0); PG8_MMA(1, 0, At, B0); PG8_BAR; PG8_SCHED;
            PG8_STAGE(PG8_SB(1, 1), b3 + hstep, voffB);
            PG8_WAIT_V(6); PG8_BAR; PG8_MMA(1, 1, At, B1); PG8_BAR;
            }
        }
        if constexpr (ALIGN_EPI) { if (wr == 0) PG8_BAR; }
        if constexpr (!Epi::AFTER_DRAIN) { E(acc, cur, wr, wc, fr, fq); S.done(cur); }
        if (!has_next) break;
#pragma unroll
        for (int a = 0; a < 2; ++a)
#pragma unroll
            for (int b = 0; b < 2; ++b)
#pragma unroll
                for (int m = 0; m < 4; ++m)
#pragma unroll
                    for (int n = 0; n < 2; ++n) acc[a][b][m][n] = (f32x4){0.f, 0.f, 0.f, 0.f};
        cur = nxt; cA = nA; cB = nB; ++ui;
        if constexpr (ALIGN_EPI) { if (wr == 1) PG8_BAR; }
    }
    PG8_WAIT_V(0);
    if constexpr (!ALIGN_EPI) { if (wr == 0) PG8_BAR; }
    PG8_BAR;
    if constexpr (Epi::AFTER_DRAIN) { E.fused(acc, cur, wr, wc, fr, fq, lds, wid, lane); S.done(cur); }
#undef PG8_SA
#undef PG8_SB
#undef PG8_STAGE
#undef PG8_LDA
#undef PG8_LDB
#undef PG8_MMA
#undef PG8_WAIT_V
#undef PG8_WAIT_L
#undef PG8_BAR
#undef PG8_SCHED
}
}
namespace pg8 {
typedef unsigned u32x2 __attribute__((ext_vector_type(2)));
__device__ __forceinline__ unsigned pkbf(float a, float b) { typedef float f2 __attribute__((ext_vector_type(2))); typedef __bf16 b2 __attribute__((ext_vector_type(2)));
    f2 v = {a, b}; b2 r = __builtin_convertvector(v, b2); return __builtin_bit_cast(unsigned, r); }
template <int ACT  , bool KMAX = false, int SCALE = 0, bool TILED = false  > struct EpiB {
    static constexpr bool PERM = true, AFTER_DRAIN = false;
    bf16_t* O; int ldc; unsigned* kmax; int kpn0, kpn1; const float* ss; bf16_t* kfrag; int kfpn;
    __device__ __forceinline__ void operator()(const f32x4 (&acc)[2][2][4][2], const Unit& u, int wr, int wc, int fr, int fq) const {
        const int row0 = u.pm * BM + wr * 64 + fr; const int col0 = u.pn * BM + wc * 32 + 8 * fq;
        float rsr[2][4]; f32x4 rsc[2][2];
        if (SCALE == 1) {
#pragma unroll
            for (int ai = 0; ai < 2; ++ai)
#pragma unroll
                for (int m = 0; m < 4; ++m) rsr[ai][m] = ss[row0 + ai * HALF + m * 16]; }
        if (SCALE == 2) {
#pragma unroll
            for (int bj = 0; bj < 2; ++bj)
#pragma unroll
                for (int n = 0; n < 2; ++n) rsc[bj][n] = *(const f32x4*)(ss + col0 + bj * HALF + 4 * n); }
        if (KMAX) if (u.pn >= kpn0 && u.pn < kpn1) {
#pragma unroll
            for (int bj = 0; bj < 2; ++bj) { float mx = 0.f;
#pragma unroll
                for (int ai = 0; ai < 2; ++ai)
#pragma unroll
                    for (int m = 0; m < 4; ++m) { const f32x4 a = acc[ai][bj][m][0], b = acc[ai][bj][m][1];
                        float q = (a[0] * a[0] + a[1] * a[1]) + (a[2] * a[2] + a[3] * a[3]) + (b[0] * b[0] + b[1] * b[1]) + (b[2] * b[2] + b[3] * b[3]);
                        if (SCALE == 1) q *= rsr[ai][m] * rsr[ai][m];
                        q += __shfl_xor(q, 16); q += __shfl_xor(q, 32); mx = fmaxf(mx, q); }
                mx = fmaxf(mx, __shfl_xor(mx, 1)); mx = fmaxf(mx, __shfl_xor(mx, 2)); mx = fmaxf(mx, __shfl_xor(mx, 4)); mx = fmaxf(mx, __shfl_xor(mx, 8));
                if (fr == 0 && fq == 0) atomicMax(kmax + (u.pm >> 5) * ((kpn1 - kpn0) * 8) + (u.pn - kpn0) * 8 + bj * 4 + wc, __float_as_uint(mx)); }
        }
#pragma unroll
        for (int ai = 0; ai < 2; ++ai)
#pragma unroll
            for (int m = 0; m < 4; ++m) { bf16_t* rowp = O + (size_t)(row0 + ai * HALF + m * 16) * ldc + col0;
#pragma unroll
                for (int bj = 0; bj < 2; ++bj) { f32x4 v0 = acc[ai][bj][m][0], v1 = acc[ai][bj][m][1];
                    if (SCALE == 1) { v0 *= rsr[ai][m]; v1 *= rsr[ai][m]; }
                    if (SCALE == 2) { v0 *= rsc[bj][0]; v1 *= rsc[bj][1]; }
                    if (ACT == 1) {
#pragma unroll
                        for (int e = 0; e < 4; ++e) { float a = fmaxf(v0[e], 0.f), b = fmaxf(v1[e], 0.f); v0[e] = a * a; v1[e] = b * b; } }
                    u32x4 w; w.x = pkbf(v0[0], v0[1]); w.y = pkbf(v0[2], v0[3]); w.z = pkbf(v1[0], v1[1]); w.w = pkbf(v1[2], v1[3]);
                    if (TILED) { const int f = row0 + ai * HALF + m * 16, tok = col0 + bj * HALF, d = f & 63, q = (tok & 31) >> 3;
                        *(u32x4*)(O + ((size_t)((f >> 6) * 1024 + (tok >> 5)) * 2048) + (((((d >> 5) * 2 + (q >> 1)) * 2 + (q & 1)) * 32 + (d & 31)) * 8)) = w; }
                    else if (kfrag != nullptr && u.pn == kfpn) { const int tok = row0 + ai * HALF + m * 16, cc = wc * 32 + 8 * fq + bj * HALF, d0 = cc & 63, ky = tok & 31;
                        const int rho = 16 * (ky >> 4) + 8 * ((ky >> 2) & 1) + 4 * ((ky >> 3) & 1) + (ky & 3);
                        *(u32x4*)(kfrag + ((size_t)((cc >> 6) * 1024 + (tok >> 5)) * 2048) + (((d0 >> 4) * 64 + ((d0 >> 3) & 1) * 32 + rho) * 8)) = w; }
                    else *(u32x4*)(rowp + bj * HALF) = w; } }
    }
};
template <bool NORM> struct EpiR {
    static constexpr bool PERM = false, AFTER_DRAIN = false;
    const float* base; float* out; int ldc; bf16_t* xb; float* ss;
    __device__ __forceinline__ void operator()(const f32x4 (&acc)[2][2][4][2], const Unit& u, int wr, int wc, int fr, int fq) const {
        const int col0 = u.pn * BM + wc * 32 + 4 * fq;
#pragma unroll
        for (int ai = 0; ai < 2; ++ai)
#pragma unroll
            for (int m = 0; m < 4; ++m) { const int r = ai * HALF + wr * 64 + m * 16 + fr; const size_t off = (size_t)(u.pm * BM + r) * ldc + col0; float q = 0.f;
#pragma unroll
                for (int bj = 0; bj < 2; ++bj)
#pragma unroll
                    for (int n = 0; n < 2; ++n) { const f32x4 bs = *(const f32x4*)(base + off + bj * HALF + n * 16); const f32x4 o = bs + acc[ai][bj][m][n]; *(f32x4*)(out + off + bj * HALF + n * 16) = o;
                        if (NORM) { q += (o[0] * o[0] + o[1] * o[1]) + (o[2] * o[2] + o[3] * o[3]); u32x2 w; w.x = pkbf(o[0], o[1]); w.y = pkbf(o[2], o[3]); *(u32x2*)(xb + off + bj * HALF + n * 16) = w; } }
                if (NORM) { q += __shfl_xor(q, 16); q += __shfl_xor(q, 32); if (fq == 0) ss[(size_t)(u.pm * BM + r) * 16 + u.pn * 4 + wc] = q; } }
    }
};
template <bool NORM> struct EpiRb {
    static constexpr bool PERM = true, AFTER_DRAIN = false;
    bf16_t* xb; int ldc; float* ss;
    __device__ __forceinline__ void operator()(const f32x4 (&acc)[2][2][4][2], const Unit& u, int wr, int wc, int fr, int fq) const {
        const int col0 = u.pn * BM + wc * 32 + 8 * fq;
#pragma unroll
        for (int ai = 0; ai < 2; ++ai)
#pragma unroll
            for (int m = 0; m < 4; ++m) { const int r = ai * HALF + wr * 64 + m * 16 + fr; bf16_t* rowp = xb + (size_t)(u.pm * BM + r) * ldc + col0; float q = 0.f;
                u32x4 bw[2];
#pragma unroll
                for (int bj = 0; bj < 2; ++bj) bw[bj] = *(const u32x4*)(rowp + bj * HALF);
#pragma unroll
                for (int bj = 0; bj < 2; ++bj) { const u32x4 b = bw[bj]; const f32x4 a0 = acc[ai][bj][m][0], a1 = acc[ai][bj][m][1];
                    u32x4 w;
                    w.x = pkbf(__uint_as_float(b.x << 16) + a0[0], __uint_as_float(b.x & 0xffff0000u) + a0[1]);
                    w.y = pkbf(__uint_as_float(b.y << 16) + a0[2], __uint_as_float(b.y & 0xffff0000u) + a0[3]);
                    w.z = pkbf(__uint_as_float(b.z << 16) + a1[0], __uint_as_float(b.z & 0xffff0000u) + a1[1]);
                    w.w = pkbf(__uint_as_float(b.w << 16) + a1[2], __uint_as_float(b.w & 0xffff0000u) + a1[3]);
                    *(u32x4*)(rowp + bj * HALF) = w;
                    if (NORM) {
#pragma unroll
                        for (int e = 0; e < 4; ++e) { const float lo = __uint_as_float(w[e] << 16), hi = __uint_as_float(w[e] & 0xffff0000u); q += lo * lo + hi * hi; } } }
                if (NORM) { q += __shfl_xor(q, 16); q += __shfl_xor(q, 32); if (fq == 0) ss[(size_t)(u.pm * BM + r) * 16 + u.pn * 4 + wc] = q; } }
    }
};
}

#define DI __device__ __forceinline__
typedef unsigned short bf16_t;
typedef short bf16x8 __attribute__((ext_vector_type(8)));
typedef float f32x16 __attribute__((ext_vector_type(16)));
typedef float f32x4 __attribute__((ext_vector_type(4)));
typedef unsigned u32x4 __attribute__((ext_vector_type(4)));
typedef unsigned u32x2 __attribute__((ext_vector_type(2)));
#define MFMA32(a, b, c) __builtin_amdgcn_mfma_f32_32x32x16_bf16((a), (b), (c), 0, 0, 0)
constexpr int T_ = 32768, S_ = 8192, NBAT = 4, DM = 1024, FF = 4096;
constexpr int LDP0 = 2048, LDP1 = 2304;
constexpr float LOG2E = 1.4426950408889634f, LN2 = 0.6931471805599453f;
constexpr float C1 = 0.125f * LOG2E;
constexpr float RMS_EPS = 1e-6f;
constexpr size_t MiB = 1024 * 1024;
constexpr size_t WS_W0QK = 0, WS_W0V = 4 * MiB, WS_W0O = 6 * MiB, WS_W1A = 8 * MiB, WS_W1V = 8 * MiB + 4608 * 1024, WS_W1O = WS_W1V + 1 * MiB,
                 WS_WM1 = WS_W1O + 2 * MiB, WS_WM2 = WS_WM1 + 16 * MiB, WS_WC1 = WS_WM2 + 16 * MiB, WS_WC2 = WS_WC1 + 2 * MiB, WS_BIAS = WS_WC2 + 64 * 1024,
                 WS_KC = 50 * MiB, WS_VCT = 51 * MiB, WS_XN = 52 * MiB, WS_BIG = 116 * MiB, WS_VT = WS_BIG + 160 * MiB, WS_XB = WS_BIG + 256 * MiB, WS_SS = WS_XB + 64 * MiB, WS_RS = WS_SS + 2 * MiB, WS_KSF = WS_RS + 1 * MiB, WS_END = WS_KSF + 16 * MiB;
static_assert(WS_BIAS + 4096 <= 50 * MiB - 20480, "ws map");
constexpr int LDS_GEMM = 131072;
constexpr int LDS_BYTES = LDS_GEMM + 16;
constexpr size_t WS_BAR = 50 * MiB - 16384;
constexpr size_t WS_QCTR = WS_BAR + 13824;
constexpr size_t WS_KMX = 50 * MiB - 20480;
constexpr int WAVE_LDS = 8704;

struct Params { const float* in[21]; float* out; unsigned char* ws; int ph_lo, ph_hi; };

DI unsigned pk2(float a, float b) { return pg8::pkbf(a, b); }
DI bf16x8 ldg8(const bf16_t* p) { return *(const bf16x8*)p; }
DI float fexp2(float x) { return __builtin_amdgcn_exp2f(x); }
DI float flog2(float x) { return __builtin_amdgcn_logf(x); }
DI float bf2f(bf16_t v) { return __uint_as_float((unsigned)v << 16); }
DI bf16x8 pack8(float a0, float a1, float a2, float a3, float a4, float a5, float a6, float a7) {
    u32x4 p; p.x = pk2(a0, a1); p.y = pk2(a2, a3); p.z = pk2(a4, a5); p.w = pk2(a6, a7); return __builtin_bit_cast(bf16x8, p); }
DI void wave_lds_sync() { asm volatile("s_waitcnt lgkmcnt(0)" ::: "memory"); }
DI float wave_sum(float v) {
#pragma unroll
    for (int o = 1; o < 64; o <<= 1) v += __shfl_xor(v, o);
    return v; }
DI f32x16 zero16() { f32x16 z;
#pragma unroll
    for (int i = 0; i < 16; ++i) z[i] = 0.f;
    return z; }
DI int vfrag_off(int d, int ch) { return ((((d >> 5) * 2 + (ch >> 1)) * 2 + (ch & 1)) * 32 + (d & 31)) * 8; }
DI int krow_of(int r) { return 16 * (r >> 4) + 8 * ((r >> 2) & 1) + 4 * ((r >> 3) & 1) + (r & 3); }

DI void transpose_item(const float* W, int K, int N, int c0, int nc, bf16_t* WT, int r0, int item, float* scr, int lane, const float* gain, bool frag) {
    const int nblk = nc >> 5, kb = item / nblk, nb = item - kb * nblk, k0 = 64 * kb, n0 = 32 * nb;
    const int col = c0 + n0 + (lane & 31); const bool ok = col < N;
    const float* src = W + (size_t)(k0 + (lane >> 5)) * N + (ok ? col : c0);
    float v[32];
#pragma unroll
    for (int i = 0; i < 32; ++i) v[i] = src[(size_t)(2 * i) * N];
    if (gain) {
        float gv[32];
#pragma unroll
        for (int i = 0; i < 32; ++i) gv[i] = gain[k0 + 2 * i + (lane >> 5)];
#pragma unroll
        for (int i = 0; i < 32; ++i) v[i] *= gv[i];
    }
#pragma unroll
    for (int i = 0; i < 32; ++i) scr[(2 * i + (lane >> 5)) * 33 + (lane & 31)] = ok ? v[i] : 0.f;
    wave_lds_sync();
    const int c = lane & 7;
#pragma unroll
    for (int j = 0; j < 4; ++j) { const int n = (lane >> 3) + 8 * j; const float* s = scr + (8 * c) * 33 + n;
        u32x4 o; o.x = pk2(s[0 * 33], s[1 * 33]); o.y = pk2(s[2 * 33], s[3 * 33]); o.z = pk2(s[4 * 33], s[5 * 33]); o.w = pk2(s[6 * 33], s[7 * 33]);
        if (frag) { const int nn = r0 + n0 + n, k = k0 + 8 * c;
            *(u32x4*)(WT + ((size_t)((k >> 4) * 8 + (nn >> 5)) * 64 + ((k >> 3) & 1) * 32 + (nn & 31)) * 8) = o; }
        else *(u32x4*)(WT + (size_t)(r0 + n0 + n) * K + k0 + 8 * c) = o; }
    wave_lds_sync();
}
struct Seg { const float* W; int K, N, c0, nc, r0; bf16_t* dst; };
DI Seg get_seg(const Params& p, int s) {
    unsigned char* ws = p.ws; Seg g;
    switch (s) {
    case 0:  g = Seg{p.in[4], 1024, 3072, 0, 1024, 0, (bf16_t*)(ws + WS_W0QK)}; break;
    case 1:  g = Seg{p.in[4], 1024, 3072, 1536, 1024, 1024, (bf16_t*)(ws + WS_W0QK)}; break;
    case 2:  g = Seg{p.in[4], 1024, 3072, 1024, 512, 0, (bf16_t*)(ws + WS_W0V)}; break;
    case 3:  g = Seg{p.in[4], 1024, 3072, 2560, 512, 512, (bf16_t*)(ws + WS_W0V)}; break;
    case 4:  g = Seg{p.in[10], 1024, 1024, 0, 1024, 0, (bf16_t*)(ws + WS_W0O)}; break;
    case 5:  g = Seg{p.in[11], 1024, 2608, 0, 1536, 0, (bf16_t*)(ws + WS_W1A)}; break;
    case 6:  g = Seg{p.in[11], 1024, 2608, 1536, 256, 1536, (bf16_t*)(ws + WS_W1A)}; break;
    case 7:  g = Seg{p.in[11], 1024, 2608, 2048, 256, 1792, (bf16_t*)(ws + WS_W1A)}; break;
    case 8:  g = Seg{p.in[11], 1024, 2608, 2560, 256, 2048, (bf16_t*)(ws + WS_W1A)}; break;
    case 9:  g = Seg{p.in[11], 1024, 2608, 1792, 256, 0, (bf16_t*)(ws + WS_W1V)}; break;
    case 10: g = Seg{p.in[11], 1024, 2608, 2304, 256, 256, (bf16_t*)(ws + WS_W1V)}; break;
    case 11: g = Seg{p.in[18], 1024, 1024, 0, 1024, 0, (bf16_t*)(ws + WS_W1O)}; break;
    case 12: g = Seg{p.in[19], 1024, 4096, 0, 4096, 0, (bf16_t*)(ws + WS_WM1)}; break;
    case 13: g = Seg{p.in[19] + (size_t)1024 * 4096, 1024, 4096, 0, 4096, 0, (bf16_t*)(ws + WS_WM1 + 8 * MiB)}; break;
    case 14: g = Seg{p.in[20], 4096, 1024, 0, 1024, 0, (bf16_t*)(ws + WS_WM2)}; break;
    case 15: g = Seg{p.in[20] + (size_t)1024 * 4096, 4096, 1024, 0, 1024, 0, (bf16_t*)(ws + WS_WM2 + 8 * MiB)}; break;
    case 16: g = Seg{p.in[13], 2048, 256, 0, 256, 0, (bf16_t*)(ws + WS_WC1)}; break;
    case 17: g = Seg{p.in[16], 2048, 256, 0, 256, 0, (bf16_t*)(ws + WS_WC1 + 1 * MiB)}; break;
    case 18: g = Seg{p.in[14], 256, 64, 0, 64, 0, (bf16_t*)(ws + WS_WC2)}; break;
    default: g = Seg{p.in[17], 256, 64, 0, 64, 0, (bf16_t*)(ws + WS_WC2 + 32 * 1024)}; break;
    }
    return g;
}
constexpr int NSEG = 20;
DI void rms_rows(const float* X, const float* g, bf16_t* obf, float* of32, int gw, int ngw, int lane) {
    f32x4 gv[4];
#pragma unroll
    for (int j = 0; j < 4; ++j) gv[j] = ((const f32x4*)g)[lane + 64 * j];
    for (int row = gw * 2; row < T_; row += ngw * 2) {
        const f32x4* xr = (const f32x4*)(X + (size_t)row * DM) + lane;
        f32x4 v[2][4]; float rstd[2];
#pragma unroll
        for (int q = 0; q < 2; ++q)
#pragma unroll
            for (int j = 0; j < 4; ++j) v[q][j] = xr[q * 256 + 64 * j];
#pragma unroll
        for (int q = 0; q < 2; ++q) { float ss = 0.f;
#pragma unroll
            for (int j = 0; j < 4; ++j) ss += (v[q][j].x * v[q][j].x + v[q][j].y * v[q][j].y) + (v[q][j].z * v[q][j].z + v[q][j].w * v[q][j].w);
            rstd[q] = rsqrtf(wave_sum(ss) * (1.f / DM) + RMS_EPS); }
#pragma unroll
        for (int q = 0; q < 2; ++q)
#pragma unroll
            for (int j = 0; j < 4; ++j) {
                const f32x4 y = v[q][j] * rstd[q] * gv[j];
                if (obf) { u32x2 w; w.x = pk2(y.x, y.y); w.y = pk2(y.z, y.w); *((u32x2*)(obf + (size_t)(row + q) * DM) + lane + 64 * j) = w; }
                if (of32) ((f32x4*)(of32 + (size_t)(row + q) * DM))[lane + 64 * j] = y;
            }
    }
}
DI void final_rows(const bf16_t* X, const float* g, float* out, int gw, int ngw, int lane) {
    f32x4 gv[4];
#pragma unroll
    for (int j = 0; j < 4; ++j) gv[j] = ((const f32x4*)g)[lane + 64 * j];
    for (int row = gw * 4; row < T_; row += ngw * 4) {
        u32x2 bw[4][4]; float rstd[4];
#pragma unroll
        for (int q = 0; q < 4; ++q)
#pragma unroll
            for (int j = 0; j < 4; ++j) bw[q][j] = *((const u32x2*)(X + (size_t)(row + q) * DM) + lane + 64 * j);
#pragma unroll
        for (int q = 0; q < 4; ++q) { float ss = 0.f;
#pragma unroll
            for (int j = 0; j < 4; ++j) { const float a = __uint_as_float(bw[q][j].x << 16), b = __uint_as_float(bw[q][j].x & 0xffff0000u), c = __uint_as_float(bw[q][j].y << 16), d = __uint_as_float(bw[q][j].y & 0xffff0000u);
                ss += (a * a + b * b) + (c * c + d * d); }
            rstd[q] = rsqrtf(wave_sum(ss) * (1.f / DM) + RMS_EPS); }
#pragma unroll
        for (int q = 0; q < 4; ++q)
#pragma unroll
            for (int j = 0; j < 4; ++j) { f32x4 v; v.x = __uint_as_float(bw[q][j].x << 16); v.y = __uint_as_float(bw[q][j].x & 0xffff0000u); v.z = __uint_as_float(bw[q][j].y << 16); v.w = __uint_as_float(bw[q][j].y & 0xffff0000u);
                ((f32x4*)(out + (size_t)(row + q) * DM))[lane + 64 * j] = v * rstd[q] * gv[j]; }
    }
}
DI void phase_prologue(const Params& p, unsigned char* lds, int wave, int lane) {
    const int gw = blockIdx.x * 8 + wave, ngw = gridDim.x * 8;
    float* scr = (float*)(lds + wave * WAVE_LDS);
    int base = 0;
    for (int s = 0; s < NSEG; ++s) {
        const Seg g = get_seg(p, s);
        const int nit = (g.K >> 6) * (g.nc >> 5);
        int first = (gw - (base % ngw) + ngw) % ngw;
        for (int it = first; it < nit; it += ngw) transpose_item(g.W, g.K, g.N, g.c0, g.nc, g.dst, g.r0, it, scr, lane, s <= 3 ? p.in[1] : (s >= 5 && s <= 10) ? p.in[1] + DM : s == 12 ? p.in[2] : s == 13 ? p.in[2] + DM : nullptr, s == 16 || s == 17);
        base += nit;
    }
    if (blockIdx.x == 0 && wave == 0) { ((unsigned*)(p.ws + WS_KMX))[lane] = 0u; ((unsigned*)(p.ws + WS_KMX))[64 + lane] = 0u; }
    {
        bf16_t* XB = (bf16_t*)(p.ws + WS_XB); float* RSt = (float*)(p.ws + WS_RS);
        for (int row = gw * 4; row < T_; row += ngw * 4) {
            const f32x4* xr = (const f32x4*)(p.in[0] + (size_t)row * DM) + lane; f32x4 v[4][4]; float ss[4];
#pragma unroll
            for (int q = 0; q < 4; ++q)
#pragma unroll
                for (int j = 0; j < 4; ++j) v[q][j] = xr[q * 256 + 64 * j];
#pragma unroll
            for (int q = 0; q < 4; ++q) { float a = 0.f;
#pragma unroll
                for (int j = 0; j < 4; ++j) a += (v[q][j].x * v[q][j].x + v[q][j].y * v[q][j].y) + (v[q][j].z * v[q][j].z + v[q][j].w * v[q][j].w);
                ss[q] = wave_sum(a); }
#pragma unroll
            for (int q = 0; q < 4; ++q) {
#pragma unroll
                for (int j = 0; j < 4; ++j) { u32x2 w; w.x = pk2(v[q][j].x, v[q][j].y); w.y = pk2(v[q][j].z, v[q][j].w); *((u32x2*)(XB + (size_t)(row + q) * DM) + lane + 64 * j) = w; }
                if (lane == 0) RSt[row + q] = rsqrtf(ss[q] * (1.f / DM) + RMS_EPS); }
        }
    }
    for (int ob = gw; ob < 512; ob += ngw) {
        const int kv = ob >> 8, j = ob & 255; const float* pos = kv ? p.in[15] : p.in[12]; const float* w1 = kv ? p.in[16] : p.in[13];
        float a = 0.f;
        for (int i = 0; i < 32; ++i) { const int k = lane + 64 * i; a += pos[k] * w1[(size_t)k * 256 + j]; }
        a = wave_sum(a);
        if (lane == 0) ((float*)(p.ws + WS_BIAS))[ob] = a;
    }
}

DI void softmax_tile(f32x16& s, float& m, float& l, float& alpha) {
    float mt = fmaxf(fmaxf(s[0], s[1]), fmaxf(s[2], s[3]));
#pragma unroll
    for (int j = 4; j < 16; j += 4) mt = fmaxf(mt, fmaxf(fmaxf(s[j], s[j + 1]), fmaxf(s[j + 2], s[j + 3])));
    mt = fmaxf(mt, __shfl_xor(mt, 32));
    const float mn = fmaxf(m, mt); alpha = fexp2(m - mn); m = mn;
    float sum = 0.f;
#pragma unroll
    for (int j = 0; j < 16; ++j) { s[j] = fexp2(s[j] - mn); sum += s[j]; }
    l = l * alpha + sum;
}
DI bool soft_core(f32x16& s, float base, float slope2, bool boundary, int tmk8, int wlim, float& mref, bool& seen, float& l, float& alpha) {
    const float b0 = base - mref;
#pragma unroll
    for (int j = 0; j < 16; ++j) s[j] = fmaf(s[j], C1, fmaf(slope2, (float)(16 * (j >> 3) + (j & 7)), b0));
    if (boundary) {
#pragma unroll
        for (int j = 0; j < 16; ++j) { const int d = tmk8 - (16 * (j >> 3) + (j & 7)); s[j] = (d >= 0 && d < wlim) ? s[j] : -INFINITY; }
    }
    float mt = fmaxf(fmaxf(s[0], s[1]), fmaxf(s[2], s[3]));
#pragma unroll
    for (int j = 4; j < 16; j += 4) mt = fmaxf(mt, fmaxf(fmaxf(s[j], s[j + 1]), fmaxf(s[j + 2], s[j + 3])));
    mt = fmaxf(mt, __shfl_xor(mt, 32));
    const bool valid = mt > -1e30f, rebase = (mt > 8.f) || (!seen && valid);
    const bool any = __any(rebase);
    alpha = 1.f;
    if (any) {
        const float delta = rebase ? mt : 0.f;
#pragma unroll
        for (int j = 0; j < 16; ++j) s[j] -= delta;
        alpha = seen ? fexp2(-delta) : 1.f; mref += delta; l *= alpha;
    }
    seen = seen || valid;
    float sum = 0.f;
#pragma unroll
    for (int j = 0; j < 16; ++j) { s[j] = fexp2(s[j]); sum += s[j]; }
    l += sum;
    return any;
}
DI void soft_tile64(const bf16_t* ktile, const bf16_t* vtile, const bf16x8 (&qf)[4], int tmk, int wlim, bool colok, bool boundary, float slope2,
                    int lane, int hf, float& m, bool& seen, float& l, f32x16& o0, f32x16& o1) {
    const bf16_t* kr = ktile + lane * 8; const bf16_t* vr = vtile + lane * 8;
    f32x16 s = zero16();
#pragma unroll
    for (int ks = 0; ks < 4; ++ks) s = MFMA32(ldg8(kr + ks * 512), qf[ks], s);
    const bf16x8 va = ldg8(vr), vc = ldg8(vr + 512), vb = ldg8(vr + 1024), vd = ldg8(vr + 1536);
    float alpha;
    if (soft_core(s, colok ? -slope2 * (float)(tmk - 8 * hf) : -INFINITY, slope2, boundary, tmk - 8 * hf, wlim, m, seen, l, alpha)) { o0 *= alpha; o1 *= alpha; }
    const bf16x8 p0 = pack8(s[0], s[1], s[2], s[3], s[4], s[5], s[6], s[7]), p1 = pack8(s[8], s[9], s[10], s[11], s[12], s[13], s[14], s[15]);
    o0 = MFMA32(va, p0, o0); o1 = MFMA32(vb, p0, o1);
    o0 = MFMA32(vc, p1, o0); o1 = MFMA32(vd, p1, o1);
}
DI void store_o64(bf16_t* orow, const f32x16& o0, const f32x16& o1, int hf) {
#pragma unroll
    for (int q = 0; q < 4; ++q) {
        u32x2 w; w.x = pk2(o0[4 * q], o0[4 * q + 1]); w.y = pk2(o0[4 * q + 2], o0[4 * q + 3]); *(u32x2*)(orow + 8 * q + 4 * hf) = w;
        u32x2 x; x.x = pk2(o1[4 * q], o1[4 * q + 1]); x.y = pk2(o1[4 * q + 2], o1[4 * q + 3]); *(u32x2*)(orow + 32 + 8 * q + 4 * hf) = x;
    }
}

DI void sb_wave(const bf16_t* QK, const bf16_t* VT, bf16_t* O, int b, int h, int tq0, int lane) {
    const int r = lane & 31, hf = lane >> 5, krow = krow_of(r), t = tq0 + r;
    const bf16_t* qp = QK + (size_t)(b * S_ + t) * LDP0 + h * 64 + 8 * hf;
    bf16x8 qf[4];
#pragma unroll
    for (int ks = 0; ks < 4; ++ks) qf[ks] = ldg8(qp + 16 * ks);
    f32x16 o0 = zero16(), o1 = zero16();
    float R = 0.f;
    for (int kb = tq0; kb >= 0; kb -= 32) {
        const bf16_t* kr = QK + (size_t)(b * S_ + kb + krow) * LDP0 + 512 + h * 64 + 8 * hf;
        f32x16 s = zero16();
#pragma unroll
        for (int ks = 0; ks < 4; ++ks) s = MFMA32(ldg8(kr + 16 * ks), qf[ks], s);
        const int tmk = t - kb;
        f32x16 lr;
        float sumLo = 0.f, sumHi = 0.f;
#pragma unroll
        for (int j = 0; j < 16; ++j) {
            const float z = s[j] * 0.125f;
            const bool valid = (tmk - (16 * (j >> 3) + 8 * hf + (j & 7))) > 0;
            const float sp = fmaxf(z, 0.f) + flog2(1.f + fexp2(-fabsf(z) * LOG2E)) * LN2;
            lr[j] = valid ? -sp : 0.f;
            s[j] = valid ? z - sp : -INFINITY;
            if (j < 8) sumLo += lr[j]; else sumHi += lr[j];
        }
        const float pLo = __shfl_xor(sumLo, 32), pHi = __shfl_xor(sumHi, 32);
        float run = R + (hf == 0 ? pHi : 0.f);
#pragma unroll
        for (int j = 15; j >= 8; --j) { const float tl = run; run += lr[j]; s[j] = fexp2((s[j] + tl) * LOG2E); }
        run = R + sumHi + pHi + (hf == 0 ? pLo : 0.f);
#pragma unroll
        for (int j = 7; j >= 0; --j) { const float tl = run; run += lr[j]; s[j] = fexp2((s[j] + tl) * LOG2E); }
        R += (sumLo + sumHi) + (pLo + pHi);
        const bf16x8 p0 = pack8(s[0], s[1], s[2], s[3], s[4], s[5], s[6], s[7]), p1 = pack8(s[8], s[9], s[10], s[11], s[12], s[13], s[14], s[15]);
        const bf16_t* vt_ = VT + ((size_t)h * 1024 + (size_t)((b * S_ + kb) >> 5)) * 2048 + lane * 8;
        o0 = MFMA32(ldg8(vt_), p0, o0); o1 = MFMA32(ldg8(vt_ + 1024), p0, o1);
        o0 = MFMA32(ldg8(vt_ + 512), p1, o0); o1 = MFMA32(ldg8(vt_ + 1536), p1, o1);
        if (__all(R < -110.f)) break;
    }
    store_o64(O + (size_t)(b * S_ + t) * DM + h * 64, o0, o1, hf);
}

constexpr int DF_KB = 32 * 144, DF_VOFF = 2 * DF_KB, DF_BUF = DF_VOFF + 128 * 80, DF_STEP = 2 * DF_BUF  , DF_FLAGS = 2 * DF_STEP, DF_QIDX = DF_FLAGS + 64, DF_X = 0  ;
DI void diff_block(const bf16_t* QK, const bf16_t* VT, bf16_t* O, const float* subln, const unsigned* kmx, float lam, int b, int h, int tqb, int wave, int lane, unsigned char* lds) {
    const int tid = wave * 64 + lane, qs = wave & 3, c = wave >> 2;
    const int r = lane & 31, hf = lane >> 5, krow = krow_of(r), tq0 = tqb + 32 * qs, t = tq0 + r;
    const float slope2 = exp2f(-2.0f * (float)(h + 1)) * LOG2E;
    const int kc_ = tid >> 8, kkey = (tid >> 3) & 31, kch = tid & 7;
    const bf16_t* kg = QK + (size_t)(b * S_ + kkey) * LDP0 + 1536 + (h * 2 + kc_) * 64 + kch * 8;
    const int klds = kc_ * DF_KB + kkey * 144 + kch * 16;
    const int vd = tid >> 2, vch = tid & 3;
    const bf16_t* vg = VT + ((size_t)(8 + 2 * h + (vd >> 6)) * 1024 + (size_t)(b * S_ >> 5)) * 2048 + vfrag_off(vd & 63, vch);
    const int vlds = DF_VOFF + vd * 80 + vch * 16;
    const int kfo = c * DF_KB + krow * 144 + hf * 16, vfo = DF_VOFF + r * 80 + hf * 16;
    bf16x8 qf[4];
#pragma unroll
    for (int ks = 0; ks < 4; ++ks) qf[ks] = ldg8(QK + (size_t)(b * S_ + t) * LDP0 + 1024 + (h * 2 + c) * 64 + 8 * hf + 16 * ks);
    f32x16 o[4];
#pragma unroll
    for (int dt = 0; dt < 4; ++dt) o[dt] = zero16();
    float m = 0.f, l = 0.f; bool seen = false;
    float ub; { float qq = 0.f;
#pragma unroll
        for (int ks = 0; ks < 4; ++ks)
#pragma unroll
            for (int e = 0; e < 8; ++e) { const float v = bf2f((bf16_t)qf[ks][e]); qq += v * v; }
        qq += __shfl_xor(qq, 32);
        const float k2 = __uint_as_float(__hip_atomic_load(kmx + b * 16 + (h * 2 + c) * 2, __ATOMIC_RELAXED, __HIP_MEMORY_SCOPE_AGENT)) + __uint_as_float(__hip_atomic_load(kmx + b * 16 + (h * 2 + c) * 2 + 1, __ATOMIC_RELAXED, __HIP_MEMORY_SCOPE_AGENT));
        ub = sqrtf(qq * k2 * 1.02f) * C1; }
    volatile unsigned* flags = (volatile unsigned*)(lds + DF_FLAGS);
    int kb = tqb + 64; int itn = 0;
    u32x4 kreg[2], vreg[2];
#pragma unroll
    for (int j = 0; j < 2; ++j) { kreg[j] = *(const u32x4*)(kg + (size_t)(kb + 32 * j) * LDP0); vreg[j] = *(const u32x4*)(vg + (size_t)((kb + 32 * j) >> 5) * 2048); }
#pragma unroll
    for (int j = 0; j < 2; ++j) { *(u32x4*)(lds + j * DF_BUF + klds) = kreg[j]; *(u32x4*)(lds + j * DF_BUF + vlds) = vreg[j]; }
    __syncthreads();
    int cur = 0;
#pragma unroll 1
    for (; kb >= 0; kb -= 64) {
        const bool more = kb > 0;
        if (more) {
#pragma unroll
            for (int j = 0; j < 2; ++j) { kreg[j] = *(const u32x4*)(kg + (size_t)(kb - 64 + 32 * j) * LDP0); vreg[j] = *(const u32x4*)(vg + (size_t)((kb - 64 + 32 * j) >> 5) * 2048); } }
        const unsigned char* B0 = lds + cur * DF_STEP; const unsigned char* B1 = B0 + DF_BUF;
        const bool a0 = kb <= tq0, a1 = kb + 32 <= tq0;
        if (a0) {
            f32x16 s1 = zero16(), s0 = zero16();
            if (a1) {
#pragma unroll
                for (int ks = 0; ks < 4; ++ks) s1 = MFMA32(*(const bf16x8*)(B1 + kfo + ks * 32), qf[ks], s1); }
#pragma unroll
            for (int ks = 0; ks < 4; ++ks) s0 = MFMA32(*(const bf16x8*)(B0 + kfo + ks * 32), qf[ks], s0);
            float alpha;
            if (a1) {
                const int tmk = t - kb - 32;
                if (soft_core(s1, -slope2 * (float)(tmk - 8 * hf), slope2, kb + 32 == tq0, tmk - 8 * hf, 1 << 30, m, seen, l, alpha)) {
#pragma unroll
                    for (int dt = 0; dt < 4; ++dt) o[dt] *= alpha; }
                const bf16x8 p0 = pack8(s1[0], s1[1], s1[2], s1[3], s1[4], s1[5], s1[6], s1[7]), p1 = pack8(s1[8], s1[9], s1[10], s1[11], s1[12], s1[13], s1[14], s1[15]);
#pragma unroll
                for (int dt = 0; dt < 4; ++dt) { o[dt] = MFMA32(*(const bf16x8*)(B1 + vfo + dt * (32 * 80)), p0, o[dt]); o[dt] = MFMA32(*(const bf16x8*)(B1 + vfo + dt * (32 * 80) + 32), p1, o[dt]); }
            }
            {
                const int tmk = t - kb;
                if (soft_core(s0, -slope2 * (float)(tmk - 8 * hf), slope2, kb == tq0, tmk - 8 * hf, 1 << 30, m, seen, l, alpha)) {
#pragma unroll
                    for (int dt = 0; dt < 4; ++dt) o[dt] *= alpha; }
                const bf16x8 p0 = pack8(s0[0], s0[1], s0[2], s0[3], s0[4], s0[5], s0[6], s0[7]), p1 = pack8(s0[8], s0[9], s0[10], s0[11], s0[12], s0[13], s0[14], s0[15]);
#pragma unroll
                for (int dt = 0; dt < 4; ++dt) { o[dt] = MFMA32(*(const bf16x8*)(B0 + vfo + dt * (32 * 80)), p0, o[dt]); o[dt] = MFMA32(*(const bf16x8*)(B0 + vfo + dt * (32 * 80) + 32), p1, o[dt]); }
            }
        }
        if (more) { unsigned char* N = lds + (cur ^ 1) * DF_STEP;
#pragma unroll
            for (int j = 0; j < 2; ++j) { *(u32x4*)(N + j * DF_BUF + klds) = kreg[j]; *(u32x4*)(N + j * DF_BUF + vlds) = vreg[j]; } }
        { const bool mine = seen && (ub - slope2 * (float)(t - kb + 1) - m < -150.f);
          const bool dn = a0 && __all(mine);
          if (lane == 0) flags[(itn & 1) * 8 + wave] = dn ? 1u : 0u; }
        __syncthreads();
        cur ^= 1;
        { const volatile unsigned* f = flags + (itn & 1) * 8; const unsigned a = f[0] & f[1] & f[2] & f[3] & f[4] & f[5] & f[6] & f[7]; ++itn; if (a) break; }
    }
    l += __shfl_xor(l, 32);
    float* X = (float*)(lds + DF_X) + qs * 4096 + lane;
    if (c == 1) { const float i1 = lam / l;
#pragma unroll
        for (int dt = 0; dt < 4; ++dt)
#pragma unroll
            for (int j = 0; j < 16; ++j) X[(dt * 16 + j) * 64] = o[dt][j] * i1; }
    __syncthreads();
    if (c == 0) {
        const float i0 = 1.f / l; float ss = 0.f;
#pragma unroll
        for (int dt = 0; dt < 4; ++dt)
#pragma unroll
            for (int j = 0; j < 16; ++j) { const float v = o[dt][j] * i0 - X[(dt * 16 + j) * 64]; o[dt][j] = v; ss += v * v; }
        ss += __shfl_xor(ss, 32);
        const float rs = rsqrtf(ss * (1.f / 128.f) + RMS_EPS) * 0.8f;
        bf16_t* orow = O + (size_t)(b * S_ + t) * DM + 512 + h * 128;
#pragma unroll
        for (int dt = 0; dt < 4; ++dt)
#pragma unroll
            for (int q = 0; q < 4; ++q) { const int d = 32 * dt + 8 * q + 4 * hf; const f32x4 gsub = *(const f32x4*)(subln + d);
                u32x2 w; w.x = pk2(o[dt][4 * q] * rs * gsub.x, o[dt][4 * q + 1] * rs * gsub.y); w.y = pk2(o[dt][4 * q + 2] * rs * gsub.z, o[dt][4 * q + 3] * rs * gsub.w);
                *(u32x2*)(orow + d) = w; }
    }
}
DI void phase_attn0(const Params& p, unsigned char* lds, int wave, int lane, int rep = 0) {
    const bf16_t* QK = (const bf16_t*)(p.ws + WS_BIG); const bf16_t* VT = (const bf16_t*)(p.ws + WS_VT); bf16_t* O = (bf16_t*)(p.ws + WS_XN);
    const float d1 = wave_sum(p.in[5][lane] * p.in[6][lane]), d2 = wave_sum(p.in[7][lane] * p.in[8][lane]);
    const float lam = expf(d1) - expf(d2) + 0.2f;
    {
        unsigned* qctr = (unsigned*)(p.ws + WS_QCTR) + rep;
        volatile unsigned* qidx = (volatile unsigned*)(lds + DF_QIDX);
        for (;;) {
            if (threadIdx.x == 0) qidx[0] = atomicAdd(qctr, 1u);
            __syncthreads();
            const unsigned idx = qidx[0];
            __syncthreads();
            if (idx >= 1024u) break;
            const int bh = idx & 15, qt = 63 - (int)(idx >> 4);
            diff_block(QK, VT, O, p.in[9], (const unsigned*)(p.ws + WS_KMX), lam, bh & 3, 3 - (bh >> 2), qt * 128, wave, lane, lds);
        }
    }
#pragma nounroll
    for (int rep = 0; rep < (PROBE_DUP == 22 ? 2 : 1); ++rep)
    for (int idx = blockIdx.x; idx < 1024; idx += gridDim.x) {
        const int bh = idx >> 5, qt = idx & 31;
        sb_wave(QK, VT, O, bh >> 3, bh & 7, qt * 256 + wave * 32, lane);
    }
}

DI float gelu_tanh(float x) { const float u = 0.7978845608028654f * (x + 0.044715f * x * x * x); const float e = fexp2(2.f * LOG2E * u); return 0.5f * x * (2.f - 2.f / (e + 1.f)); }
DI void phase_compress(const Params& p, unsigned char* lds, int wave, int lane) {
    const bf16_t* P1 = (const bf16_t*)(p.ws + WS_BIG);
    bf16_t* H = (bf16_t*)lds;
    const int r = lane & 31, hf = lane >> 5;
    for (int u = blockIdx.x; u < 512; u += gridDim.x) {
        const int kv = u >> 8, b = (u >> 6) & 3, g = (u >> 4) & 3, it = u & 15, i0 = 32 * it;
        const bf16_t* W1 = (const bf16_t*)(p.ws + WS_WC1 + (size_t)kv * MiB); const bf16_t* W2 = (const bf16_t*)(p.ws + WS_WC2 + (size_t)kv * 32 * 1024);
        const float* bias = (const float*)(p.ws + WS_BIAS) + kv * 256;
        unsigned char* AL = lds + 17408;
        { const bf16_t* src = P1 + (size_t)(b * S_) * LDP1 + 1024 + kv * 256 + g * 64;
          u32x4 tmp[9];
#pragma unroll
          for (int j = 0; j < 9; ++j) { const int c = min((int)threadIdx.x + 512 * j, 528 * 8 - 1), tl = c >> 3, ch = c & 7; const int tok = min(16 * i0 + tl, S_ - 1);
              tmp[j] = *(const u32x4*)(src + (size_t)tok * LDP1 + ch * 8); }
#pragma unroll
          for (int j = 0; j < 9; ++j) { const int c = (int)threadIdx.x + 512 * j, tl = c >> 3, ch = c & 7;
              if (c < 528 * 8) *(u32x4*)(AL + tl * 128 + (tl >> 7) * 128 + ((ch ^ ((tl >> 4) & 7)) << 4)) = tmp[j]; } }
        __syncthreads();
        const bf16_t* bp = W1 + (size_t)wave * 512 + lane * 8;
        f32x16 acc = zero16();
        bf16x8 rb[4][8];
#pragma unroll
        for (int gq = 0; gq < 4; ++gq)
#pragma unroll
            for (int u8 = 0; u8 < 8; ++u8) rb[gq][u8] = ldg8(bp + (size_t)(gq * 8 + u8) * 4096);
#pragma unroll 1
        for (int k0 = 0; k0 < 128; k0 += 32) {
#pragma unroll
            for (int gq = 0; gq < 4; ++gq) {
#pragma unroll
                for (int u8 = 0; u8 < 8; ++u8) { const int kk = k0 + gq * 8 + u8; const int tl = 16 * r + (kk >> 2), ch = 2 * (kk & 3) + hf;
                    acc = MFMA32(*(const bf16x8*)(AL + tl * 128 + (tl >> 7) * 128 + ((ch ^ ((tl >> 4) & 7)) << 4)), rb[gq][u8], acc); }
                if (k0 + 32 < 128) {
#pragma unroll
                    for (int u8 = 0; u8 < 8; ++u8) rb[gq][u8] = ldg8(bp + (size_t)(k0 + 32 + gq * 8 + u8) * 4096); }
            }
        }
        const float bj = bias[32 * wave + r];
#pragma unroll
        for (int j = 0; j < 16; ++j) { const int row = (j & 3) + 8 * (j >> 2) + 4 * hf; const float hval = gelu_tanh(acc[j] + bj);
            H[row * 264 + 32 * wave + r] = (bf16_t)(pk2(hval, 0.f) & 0xffffu); }
        __syncthreads();
        if (wave < 2) {
            f32x16 a2 = zero16();
            const bf16_t* hp = H + r * 264 + 8 * hf; const bf16_t* wp = W2 + (size_t)(32 * wave + r) * 256 + 8 * hf;
#pragma unroll
            for (int k2 = 0; k2 < 16; ++k2) a2 = MFMA32(*(const bf16x8*)(hp + 16 * k2), ldg8(wp + 16 * k2), a2);
            const int d = 32 * wave + r;
            if (kv == 0) {
                float mx = 0.f;
#pragma unroll
                for (int j = 0; j < 16; ++j) { float q = a2[j] * a2[j]; q += __shfl_xor(q, 1); q += __shfl_xor(q, 2); q += __shfl_xor(q, 4); q += __shfl_xor(q, 8); q += __shfl_xor(q, 16); mx = fmaxf(mx, q); }
                mx = fmaxf(mx, __shfl_xor(mx, 32));
                if (lane == 0) atomicMax((unsigned*)(p.ws + WS_KMX) + 96 + (b * 4 + g) * 2 + wave, __float_as_uint(mx)); }
            if (kv == 0) { bf16_t* kc = (bf16_t*)(p.ws + WS_KC) + (size_t)((b * 4 + g) * 512) * 64;
#pragma unroll
                for (int j = 0; j < 16; ++j) { const int i = i0 + (j & 3) + 8 * (j >> 2) + 4 * hf; kc[(size_t)i * 64 + d] = i < 511 ? (bf16_t)(pk2(a2[j], 0.f) & 0xffffu) : (bf16_t)0; }
            } else { bf16_t* vct = (bf16_t*)(p.ws + WS_VCT) + ((size_t)((b * 4 + g) * 16 + it) * 64 + d) * 32 - i0;
#pragma unroll
                for (int q = 0; q < 8; ++q) { const int j = (q >> 1) * 4 + (q & 1) * 2; const int i = i0 + (j & 3) + 8 * (j >> 2) + 4 * hf;
                    const float lo = a2[j], hi = (i + 1 < 511) ? a2[j + 1] : 0.f; *(unsigned*)(vct + i) = pk2(lo, hi); }
            }
        }
        __syncthreads();
    }
}

constexpr int NS_VOFF = 4608, NS_BUF = 9728, NS_BASE = 8 * WAVE_LDS;
DI f32x16 qk_lds(const unsigned char* B, const bf16x8 (&qf)[4], int krow, int hf) {
    f32x16 s = zero16();
#pragma unroll
    for (int ks = 0; ks < 4; ++ks) s = MFMA32(*(const bf16x8*)(B + krow * 144 + hf * 16 + ks * 32), qf[ks], s);
    return s; }
DI void pv_lds(const unsigned char* B, const bf16x8& p0, const bf16x8& p1, f32x16& o0, f32x16& o1, int r, int hf) {
    const unsigned char* v = B + NS_VOFF + r * 80 + hf * 16;
    o0 = MFMA32(*(const bf16x8*)(v), p0, o0); o1 = MFMA32(*(const bf16x8*)(v + 32 * 80), p0, o1);
    o0 = MFMA32(*(const bf16x8*)(v + 32), p1, o0); o1 = MFMA32(*(const bf16x8*)(v + 32 * 80 + 32), p1, o1); }
DI void nsa_block(const bf16_t* P1, const bf16_t* VT1, const bf16_t* KSF, const bf16_t* KC, const bf16_t* VCT, bf16_t* O, const unsigned* kmx, int b, int g, int t0b, int wave, int lane, unsigned char* lds) {
    unsigned char* wl = lds + wave * WAVE_LDS; unsigned char* SB = lds + NS_BASE;
    const int t0w = t0b + 8 * wave, tid = wave * 64 + lane;
    const bool kst = wave < 4;
    const int st_row = kst ? (tid >> 3) : ((tid - 256) >> 2), st_ch = kst ? (tid & 7) : ((tid - 256) & 3);
    const int st_dst = kst ? st_row * 144 + st_ch * 16 : NS_VOFF + st_row * 80 + st_ch * 16;
    u32x4 sreg = {0u, 0u, 0u, 0u};
    float* impA = (float*)wl; float* impB = impA + 1024; unsigned long long* selm = (unsigned long long*)(wl + 8192);
    const int r = lane & 31, hf = lane >> 5, tk = r >> 2, hh = r & 3, krow = krow_of(r);
    const int t = t0w + tk, head = g * 4 + hh, tmax = t0w + 7;
    const float slope2 = exp2f(-0.5f * (float)(head + 1)) * LOG2E;
    const bf16_t* prow = P1 + (size_t)(b * S_ + t) * LDP1;
    bf16x8 qf[4];
#pragma unroll
    for (int ks = 0; ks < 4; ++ks) qf[ks] = ldg8(prow + head * 64 + 8 * hf + 16 * ks);
    const float gc = 1.f / (1.f + __expf(-bf2f(prow[2048 + head * 3 + 0]))), gs = 1.f / (1.f + __expf(-bf2f(prow[2048 + head * 3 + 1]))), gwn = 1.f / (1.f + __expf(-bf2f(prow[2048 + head * 3 + 2])));
#pragma unroll
    for (int i = 0; i < 16; ++i) { impA[lane + 64 * i] = 0.f; impB[lane + 64 * i] = 0.f; }
    wave_lds_sync();
    const int nmax = tmax >= 31 ? ((tmax - 31) >> 4) + 1 : 0, ntile = (nmax + 31) >> 5;
    const bf16_t* kcb = KC + (size_t)((b * 4 + g) * 512) * 64;
    const bf16_t* vcb = VCT + (size_t)((b * 4 + g) * 64) * 512;
    int lo_b = 0, lo_w = 0;
    { float qq = 0.f;
#pragma unroll
      for (int ks = 0; ks < 4; ++ks)
#pragma unroll
          for (int e = 0; e < 8; ++e) { const float v = bf2f((bf16_t)qf[ks][e]); qq += v * v; }
      qq += __shfl_xor(qq, 32);
      const unsigned* kcm = kmx + 96 + (b * 4 + g) * 2;
      const float kc2 = __uint_as_float(__hip_atomic_load(kcm, __ATOMIC_RELAXED, __HIP_MEMORY_SCOPE_AGENT)) + __uint_as_float(__hip_atomic_load(kcm + 1, __ATOMIC_RELAXED, __HIP_MEMORY_SCOPE_AGENT));
      const float ubc = sqrtf(qq * kc2 * 1.02f) * C1;
      const float Dcol = (150.f + 2.f * ubc) / slope2 + 15.f;
      const float f = (((float)(t - 31) - Dcol) * (1.f / 16.f) - 31.f) * (1.f / 32.f);
      int lo = f > 0.f ? (int)floorf(f) : 0;
#pragma unroll
      for (int o = 1; o < 64; o <<= 1) lo = min(lo, __shfl_xor(lo, o));
      lo_w = lo;
      volatile int* xl = (volatile int*)(SB + 2 * NS_BUF + 64);
      if (lane == 0) xl[wave] = lo_w;
      __syncthreads();
      lo_b = min(min(min(xl[0], xl[1]), min(xl[2], xl[3])), min(min(xl[4], xl[5]), min(xl[6], xl[7]))); }
    float m = -1e30f, l = 0.f;
    const int tmaxb = t0b + 63, ntb = ((tmaxb >= 31 ? ((tmaxb - 31) >> 4) + 1 : 0) + 31) >> 5;
#define NS_CMP_SRC(n) (kst ? kcb + (size_t)(32 * (n) + st_row) * 64 + st_ch * 8 : vcb + (size_t)(n) * 2048 + st_row * 32 + st_ch * 8)
    if (ntb > lo_b) {
        if (kst) sreg = *(const u32x4*)NS_CMP_SRC(lo_b);
        if (kst) *(u32x4*)(SB + st_dst) = sreg;
        __syncthreads();
#pragma unroll 1
        for (int it = lo_b; it < ntb; ++it) {
            if (kst && it + 1 < ntb) sreg = *(const u32x4*)NS_CMP_SRC(it + 1);
            const unsigned char* B = SB + ((it - lo_b) & 1) * NS_BUF;
            if (it >= lo_w && it < ntile) {
                const int ib = 32 * it;
                f32x16 s = qk_lds(B, qf, krow, hf);
#pragma unroll
                for (int j = 0; j < 16; ++j) { const int dist = t - 31 - 16 * (ib + 16 * (j >> 3) + 8 * hf + (j & 7)); s[j] = dist >= 0 ? s[j] * C1 - slope2 * (float)dist : -INFINITY; }
                float alpha; softmax_tile(s, m, l, alpha);
            }
            if (kst && it + 1 < ntb) *(u32x4*)(SB + ((it + 1 - lo_b) & 1) * NS_BUF + st_dst) = sreg;
            __syncthreads();
        }
    }
    l += __shfl_xor(l, 32);
    const float inv = (t >= 31) ? 1.f / l : 0.f;
    f32x16 of0 = zero16(), of1 = zero16();
    if (ntb > lo_b) {
        sreg = *(const u32x4*)NS_CMP_SRC(lo_b);
        *(u32x4*)(SB + st_dst) = sreg;
        __syncthreads();
    }
#pragma unroll 1
    for (int it = lo_b; it < ntb; ++it) {
        if (it + 1 < ntb) sreg = *(const u32x4*)NS_CMP_SRC(it + 1);
        const unsigned char* B = SB + ((it - lo_b) & 1) * NS_BUF;
        if (it >= lo_w && it < ntile) {
        const int ib = 32 * it;
        f32x16 s = qk_lds(B, qf, krow, hf);
#pragma unroll
        for (int j = 0; j < 16; ++j) { const int dist = t - 31 - 16 * (ib + 16 * (j >> 3) + 8 * hf + (j & 7)); s[j] = dist >= 0 ? fexp2(s[j] * C1 - slope2 * (float)dist - m) * inv : 0.f; }
#pragma unroll
        for (int q = 0; q < 4; ++q) {
            float gsum = (s[4 * q] + s[4 * q + 1]) + (s[4 * q + 2] + s[4 * q + 3]), e = s[4 * q + 3];
            gsum += __shfl_xor(gsum, 1); gsum += __shfl_xor(gsum, 2); e += __shfl_xor(e, 1); e += __shfl_xor(e, 2);
            const int ssel = (ib >> 2) + 4 * (q >> 1) + 2 * hf + (q & 1);
            if (hh == 0) { impA[tk * 128 + ssel] = gsum; if (ssel + 1 < 128) impB[tk * 128 + ssel + 1] = e; }
        }
        const bf16x8 p0 = pack8(s[0], s[1], s[2], s[3], s[4], s[5], s[6], s[7]), p1 = pack8(s[8], s[9], s[10], s[11], s[12], s[13], s[14], s[15]);
        pv_lds(B, p0, p1, of0, of1, r, hf);
        }
        if (it + 1 < ntb) *(u32x4*)(SB + ((it + 1 - lo_b) & 1) * NS_BUF + st_dst) = sreg;
        __syncthreads();
    }
#undef NS_CMP_SRC
    of0 *= gc; of1 *= gc;
    wave_lds_sync();
    const unsigned long long lt_mask = (1ull << lane) - 1ull;
    for (int k2 = 0; k2 < 8; ++k2) {
        const int cur = (t0w + k2) >> 6;
        unsigned long long ma, mb;
        if (cur < 16) { ma = __ballot(lane <= cur); mb = 0ull; }
        else {
            const float va = impA[k2 * 128 + lane] + impB[k2 * 128 + lane], vb = impA[k2 * 128 + 64 + lane] + impB[k2 * 128 + 64 + lane];
            const int sa = lane, sb = lane + 64;
            const unsigned ka = (sa >= 1 && sa <= cur - 2) ? __float_as_uint(va) + 1u : 0u, kb = (sb <= cur - 2) ? __float_as_uint(vb) + 1u : 0u;
            unsigned tau = 0u;
            for (int bit = 31; bit >= 0; --bit) { const unsigned trial = tau | (1u << bit);
                const int cnt = __popcll(__ballot(ka >= trial)) + __popcll(__ballot(kb >= trial)); if (cnt >= 13) tau = trial; }
            const unsigned long long eqA = __ballot(ka == tau), eqB = __ballot(kb == tau);
            const int need = 13 - __popcll(__ballot(ka > tau)) - __popcll(__ballot(kb > tau));
            const int rankA = __popcll(eqA & lt_mask), rankB = __popcll(eqA) + __popcll(eqB & lt_mask);
            const bool selA = (ka > tau) || (ka == tau && rankA < need) || sa == 0 || sa == cur || sa == cur - 1;
            const bool selB = (kb > tau) || (kb == tau && rankB < need) || sb == cur || sb == cur - 1;
            ma = __ballot(selA); mb = __ballot(selB);
        }
        if (lane == 0) { selm[2 * k2] = ma; selm[2 * k2 + 1] = mb; }
    }
    wave_lds_sync();
    const unsigned long long mlo = selm[2 * tk], mhi = selm[2 * tk + 1];
    unsigned long long ulo = 0ull, uhi = 0ull;
#pragma unroll
    for (int k2 = 0; k2 < 8; ++k2) { ulo |= selm[2 * k2]; uhi |= selm[2 * k2 + 1]; }
    const bf16_t* ksb = KSF + ((size_t)g * 1024 + (size_t)(b * S_ >> 5)) * 2048; const bf16_t* vsb = VT1 + ((size_t)g * 1024 + (size_t)(b * S_ >> 5)) * 2048;
    const bf16_t* kwb = P1 + (size_t)(b * S_) * LDP1 + 1792 + g * 64; const bf16_t* vwb = VT1 + ((size_t)(4 + g) * 1024 + (size_t)(b * S_ >> 5)) * 2048;
    {
        f32x16 o0 = zero16(), o1 = zero16(); m = 0.f; l = 0.f; bool seen = false;
        float ubq; { float qq = 0.f;
#pragma unroll
            for (int ks = 0; ks < 4; ++ks)
#pragma unroll
                for (int e = 0; e < 8; ++e) { const float v = bf2f((bf16_t)qf[ks][e]); qq += v * v; }
            qq += __shfl_xor(qq, 32);
            const float k2 = __uint_as_float(__hip_atomic_load(kmx + 64 + b * 8 + 2 * g, __ATOMIC_RELAXED, __HIP_MEMORY_SCOPE_AGENT)) + __uint_as_float(__hip_atomic_load(kmx + 64 + b * 8 + 2 * g + 1, __ATOMIC_RELAXED, __HIP_MEMORY_SCOPE_AGENT));
            ubq = sqrtf(qq * k2 * 1.02f) * C1; }
        bool stop = false;
#pragma unroll 1
        for (int half = 1; half >= 0 && !stop; --half) {
            unsigned long long U = half ? uhi : ulo; const unsigned long long mine = half ? mhi : mlo;
            U = ((unsigned long long)__builtin_amdgcn_readfirstlane((unsigned)(U >> 32)) << 32) | (unsigned long long)__builtin_amdgcn_readfirstlane((unsigned)U);
            while (U) {
                const int bit = 63 - __builtin_clzll(U); U &= ~(1ull << bit);
                const bool colok = (mine >> bit) & 1ull;
                const int kb0 = (bit + 64 * half) * 64;
                if (__all(seen && (ubq - slope2 * (float)(t - (kb0 + 63)) - m < -150.f))) { stop = true; break; }
#pragma unroll 1
                for (int sub = 0; sub < 2; ++sub) { const int kb = kb0 + 32 * sub; if (kb > tmax) break;
                    soft_tile64(ksb + (size_t)(kb >> 5) * 2048, vsb + (size_t)(kb >> 5) * 2048, qf, t - kb, 1 << 30, colok, kb + 31 > t0w, slope2, lane, hf, m, seen, l, o0, o1); }
            }
        }
        l += __shfl_xor(l, 32);
        const float sc = gs / l; of0 += o0 * sc; of1 += o1 * sc;
    }
    {
        f32x16 o0 = zero16(), o1 = zero16(); m = 0.f; l = 0.f; bool seen = false;
        int lo = t0w - 511; if (lo < 0) lo = 0;
        const int kb_lo = lo & ~31, kb_hi = t0w & ~31;
        int lob = t0b - 511; if (lob < 0) lob = 0;
        const int kb_lob = lob & ~31, kb_hib = t0b + 32, nwt = ((kb_hib - kb_lob) >> 5) + 1;
#define NS_WIN_SRC(kb_) (kst ? kwb + (size_t)((kb_) + st_row) * LDP1 + st_ch * 8 : vwb + (size_t)((kb_) >> 5) * 2048 + vfrag_off(st_row, st_ch))
        sreg = *(const u32x4*)NS_WIN_SRC(kb_hib);
        *(u32x4*)(SB + st_dst) = sreg;
        __syncthreads();
#pragma unroll 1
        for (int n = 0; n < nwt; ++n) {
            const int kb = kb_hib - 32 * n;
            if (n + 1 < nwt) sreg = *(const u32x4*)NS_WIN_SRC(kb - 32);
            const unsigned char* B = SB + (n & 1) * NS_BUF;
            if (kb >= kb_lo && kb <= kb_hi) {
                f32x16 sc_ = qk_lds(B, qf, krow, hf);
                float alpha;
                if (soft_core(sc_, -slope2 * (float)(t - kb - 8 * hf), slope2, (kb + 31 > t0w) || (tmax - kb >= 512), t - kb - 8 * hf, 512, m, seen, l, alpha)) { o0 *= alpha; o1 *= alpha; }
                const bf16x8 p0 = pack8(sc_[0], sc_[1], sc_[2], sc_[3], sc_[4], sc_[5], sc_[6], sc_[7]), p1 = pack8(sc_[8], sc_[9], sc_[10], sc_[11], sc_[12], sc_[13], sc_[14], sc_[15]);
                pv_lds(B, p0, p1, o0, o1, r, hf);
            }
            if (n + 1 < nwt) *(u32x4*)(SB + ((n + 1) & 1) * NS_BUF + st_dst) = sreg;
            __syncthreads();
        }
#undef NS_WIN_SRC
        l += __shfl_xor(l, 32);
        const float sc = gwn / l; of0 += o0 * sc; of1 += o1 * sc;
    }
    store_o64(O + (size_t)(b * S_ + t) * DM + head * 64, of0, of1, hf);
}
DI void phase_nsa(const Params& p, unsigned char* lds, int wave, int lane, int rep = 0) {
    const bf16_t* P1 = (const bf16_t*)(p.ws + WS_BIG); const bf16_t* VT1 = (const bf16_t*)(p.ws + WS_VT);
    const bf16_t* KC = (const bf16_t*)(p.ws + WS_KC); const bf16_t* VCT = (const bf16_t*)(p.ws + WS_VCT); bf16_t* O = (bf16_t*)(p.ws + WS_XN);
    unsigned* qctr = (unsigned*)(p.ws + WS_QCTR) + 8 + rep;
    volatile unsigned* qidx = (volatile unsigned*)(lds + NS_BASE + 2 * NS_BUF);
    for (;;) {
        if (threadIdx.x == 0) qidx[0] = atomicAdd(qctr, 1u);
        __syncthreads();
        const unsigned idx = qidx[0];
        __syncthreads();
        if (idx >= 2048u) break;
        const int bg = idx & 15, tile = 127 - (int)(idx >> 4);
        nsa_block(P1, VT1, (const bf16_t*)(p.ws + WS_KSF), KC, VCT, O, (const unsigned*)(p.ws + WS_KMX), bg & 3, 3 - (bg >> 2), tile * 64, wave, lane, lds);
    }
}

#define XB_TMO      128
#define XB_XCNT(j)  (256  + 64 * (j))
#define XB_XSUB(j)  (1280 + 64 * (j))
#define XB_XGEN(j)  (2304 + 64 * (j))
#define XB_TOP      3328
#define XB_TOPGEN   3392
#define XCD_BAR_WORDS 3456
#define XB_SPIN_CAP (1u << 18)
#define LAS __attribute__((address_space(3)))

__device__ __forceinline__ unsigned xb_ld(unsigned* p)              { return __hip_atomic_load(p, __ATOMIC_RELAXED, __HIP_MEMORY_SCOPE_AGENT); }
__device__ __forceinline__ unsigned xb_add(unsigned* p, unsigned v) { return __hip_atomic_fetch_add(p, v, __ATOMIC_RELAXED, __HIP_MEMORY_SCOPE_AGENT); }
__device__ __forceinline__ unsigned xb_xcc_id() { return (unsigned)__builtin_amdgcn_s_getreg((3 << 11) | 20) & 0xFu; }
#define XB_SPIN(cond, bar) do { unsigned _sp = 0; while (cond) { __builtin_amdgcn_s_sleep(1); \
    if ((++_sp & 255u) == 0u) { if (xb_ld(&(bar)[XB_TMO])) break; if (_sp > XB_SPIN_CAP) { atomicAdd(&(bar)[XB_TMO], 1u); break; } } } } while (0)

struct XcdBarrier {
    unsigned* bar; unsigned x;
    volatile LAS unsigned* st;
};

__device__ __forceinline__ XcdBarrier xcd_barrier_post(unsigned* bar, volatile LAS unsigned* st) {
    XcdBarrier b; b.bar = bar; b.x = xb_xcc_id(); b.st = st;
    if (threadIdx.x == 0) (void)xb_add(&bar[XB_XCNT(b.x)], 1u);
    return b;
}
__device__ __forceinline__ void xcd_barrier_complete(unsigned* bar, unsigned x, unsigned& nloc, unsigned& nx) {
    const unsigned G = gridDim.x * gridDim.y * gridDim.z;
    unsigned sum, cnt, mine, sp = 0u;
    for (;;) {
        sum = 0u; cnt = 0u; mine = 0u;
#pragma unroll
        for (unsigned j = 0; j < 16; ++j) { const unsigned c = xb_ld(&bar[XB_XCNT(j)]); sum += c; cnt += (c > 0u) ? 1u : 0u; mine = (j == x) ? c : mine; }
        if (sum == G) break;
        __builtin_amdgcn_s_sleep(1);
        if ((++sp & 255u) == 0u) { if (xb_ld(&bar[XB_TMO])) break; if (sp > XB_SPIN_CAP) { atomicAdd(&bar[XB_TMO], 1u); break; } }
    }
    nloc = mine > 0u ? mine : 1u; nx = cnt > 0u ? cnt : 1u;
}

__device__ __forceinline__ void xcd_barrier(const XcdBarrier& b) {
    asm volatile("s_waitcnt vmcnt(0)" ::: "memory");
    __syncthreads();
    if (threadIdx.x == 0) {
        unsigned* bar = b.bar;
        __builtin_amdgcn_s_waitcnt(0);
        unsigned nloc = b.st[0], nx = b.st[1];
        if (nloc == 0u) { xcd_barrier_complete(bar, b.x, nloc, nx); b.st[0] = nloc; b.st[1] = nx; }
        const unsigned old = xb_add(&bar[XB_XSUB(b.x)], 1u);
        const unsigned gen = old / nloc;
        if (old + 1u == (gen + 1u) * nloc) {
            __builtin_amdgcn_fence(__ATOMIC_RELEASE, "agent");
            asm volatile("s_waitcnt vmcnt(0)" ::: "memory");
            const unsigned og = xb_add(&bar[XB_TOP], 1u);
            const unsigned tg = og / nx;
            if (og + 1u == (tg + 1u) * nx) xb_add(&bar[XB_TOPGEN], 1u);
            else XB_SPIN(xb_ld(&bar[XB_TOPGEN]) == tg, bar);
            __builtin_amdgcn_fence(__ATOMIC_ACQUIRE, "agent");
            xb_add(&bar[XB_XGEN(b.x)], 1u);
            asm volatile("s_waitcnt vmcnt(0)" ::: "memory");
        } else {
            XB_SPIN(xb_ld(&bar[XB_XGEN(b.x)]) == gen, bar);
            __builtin_amdgcn_fence(__ATOMIC_ACQUIRE, "agent");
            asm volatile("s_waitcnt vmcnt(0)" ::: "memory");
        }
    }
    __syncthreads();
}

static_assert(XCD_BAR_WORDS * 4 == 13824, "queue counter sits right behind the barrier words");
DI void rs_for_units(int M, int N, bool by_col, const float* SS, float* RS) {
    pg8::StaticOrder S; S.init(M, N, (int)gridDim.x, (int)blockIdx.x);
    pg8::Unit u; int last = -1; const int tid = threadIdx.x;
    for (int i = 0; S.next(i, u); ++i) {
        const int panel = by_col ? u.pn : u.pm;
        if (panel == last) continue;
        last = panel;
        const int row = panel * 256 + (tid >> 1);
        const f32x4* pp = (const f32x4*)(SS + (size_t)row * 16 + (tid & 1) * 8);
        const f32x4 a = pp[0], b = pp[1];
        float v = ((a[0] + a[1]) + (a[2] + a[3])) + ((b[0] + b[1]) + (b[2] + b[3]));
        v += __shfl_xor(v, 1);
        if ((tid & 1) == 0) RS[row] = rsqrtf(v * (1.f / DM) + RMS_EPS);
    }
    asm volatile("s_waitcnt vmcnt(0)" ::: "memory");
    __syncthreads();
}
template <class Epi> DI void run_gemm(unsigned char* lds, const bf16_t* A, const bf16_t* Bt, int M, int N, int K, const Epi& E) {
    pg8::Gemm g{A, Bt, M, N, K}; pg8::StaticOrder S; S.init(M, N, (int)gridDim.x, (int)blockIdx.x);
    pg8::gemm_phase<Epi, pg8::StaticOrder, true, true>((PG8_LAS unsigned char*)lds, g, S, E);
}
#ifndef PROBE_DUP
#define PROBE_DUP 0
#endif
#ifndef ONLY_PHASE
#define ONLY_PHASE -1
#endif
#define PH_EN(n) (ONLY_PHASE < 0 || ONLY_PHASE == (n))
constexpr int NPHASE = 16;
__global__ void __launch_bounds__(512) trunk_fwd(Params p) {
    extern __shared__ __attribute__((aligned(16))) unsigned char lds[];
    cg::grid_group grid = cg::this_grid();
    const int tid = threadIdx.x, lane = tid & 63, wave = __builtin_amdgcn_readfirstlane(tid >> 6);
    const int gw = blockIdx.x * 8 + wave, ngw = gridDim.x * 8;
    unsigned char* ws = p.ws;
    bf16_t* XN = (bf16_t*)(ws + WS_XN); bf16_t* BIG = (bf16_t*)(ws + WS_BIG); bf16_t* VT = (bf16_t*)(ws + WS_VT);
    const int lo = p.ph_lo, hi = p.ph_hi;
    if (hi > 1000) grid.sync();
    if (tid < 4) ((unsigned*)(lds + LDS_GEMM))[tid] = 0u;
    __syncthreads();
    XcdBarrier xbar = xcd_barrier_post((unsigned*)(ws + WS_BAR), (volatile LAS unsigned*)(lds + LDS_GEMM));
#define IN(k) (PH_EN(k) && lo <= (k) && (k) < hi)
#define SEAM(k) do { if ((k) + 1 < hi) { _Pragma("nounroll") for (int rep_ = 0; rep_ < (PROBE_DUP == 99 ? 3 : 1); ++rep_) xcd_barrier(xbar); } } while (0)
    if (IN(0)) {
#pragma nounroll
        for (int rep = 0; rep < (PROBE_DUP == 100 ? 2 : 1); ++rep) phase_prologue(p, lds, wave, lane);
        SEAM(0); }
    bf16_t* XB = (bf16_t*)(ws + WS_XB); float* SS = (float*)(ws + WS_SS); float* RS = (float*)(ws + WS_RS);
#define RSTD_PASS() do { for (int r4 = gw * 4; r4 < T_; r4 += ngw * 4) { float v = SS[(size_t)r4 * 16 + lane]; v += __shfl_xor(v, 1); v += __shfl_xor(v, 2); v += __shfl_xor(v, 4); v += __shfl_xor(v, 8); if ((lane & 15) == 0) RS[r4 + (lane >> 4)] = rsqrtf(v * (1.f / DM) + RMS_EPS); } } while (0)
    if (IN(1)) { run_gemm(lds, XB, (const bf16_t*)(ws + WS_W0QK), T_, 2048, DM, pg8::EpiB<0, true, 1>{BIG, LDP0, (unsigned*)(ws + WS_KMX), 6, 8, RS, nullptr, -1});
                 run_gemm(lds, (const bf16_t*)(ws + WS_W0V), XB, 1024, T_, DM, pg8::EpiB<0, false, 2, true>{VT, T_, nullptr, 0, 0, RS, nullptr, -1}); SEAM(1); }
    if (IN(2)) {
#pragma nounroll
        for (int rep = 0; rep < (PROBE_DUP == 2 ? 2 : 1); ++rep) phase_attn0(p, lds, wave, lane, rep);
        SEAM(2); }
    if (IN(3)) { run_gemm(lds, XN, (const bf16_t*)(ws + WS_W0O), T_, DM, DM, pg8::EpiRb<true>{XB, DM, SS}); SEAM(3); }
    if (IN(5)) { rs_for_units(T_, FF, false, SS, RS);
                 run_gemm(lds, XB, (const bf16_t*)(ws + WS_WM1), T_, FF, DM, pg8::EpiB<1, false, 1>{BIG, FF, nullptr, 0, 0, RS, nullptr, -1}); SEAM(5); }
    if (IN(6)) { run_gemm(lds, BIG, (const bf16_t*)(ws + WS_WM2), T_, DM, FF, pg8::EpiRb<true>{XB, DM, SS}); SEAM(6); }
    if (IN(8)) { rs_for_units(T_, LDP1, false, SS, RS); rs_for_units(512, T_, true, SS, RS);
                 run_gemm(lds, XB, (const bf16_t*)(ws + WS_W1A), T_, LDP1, DM, pg8::EpiB<0, true, 1>{BIG, LDP1, (unsigned*)(ws + WS_KMX) + 64, 6, 7, RS, (bf16_t*)(ws + WS_KSF), 6});
                 run_gemm(lds, (const bf16_t*)(ws + WS_W1V), XB, 512, T_, DM, pg8::EpiB<0, false, 2, true>{VT, T_, nullptr, 0, 0, RS, nullptr, -1}); SEAM(8); }
    if (IN(9)) {
#pragma nounroll
        for (int rep = 0; rep < (PROBE_DUP == 9 ? 2 : 1); ++rep) phase_compress(p, lds, wave, lane);
        SEAM(9); }
    if (IN(10)) {
#pragma nounroll
        for (int rep = 0; rep < (PROBE_DUP == 10 ? 2 : 1); ++rep) phase_nsa(p, lds, wave, lane, rep);
        SEAM(10); }
    if (IN(11)) { run_gemm(lds, XN, (const bf16_t*)(ws + WS_W1O), T_, DM, DM, pg8::EpiRb<true>{XB, DM, SS}); SEAM(11); }
    if (IN(13)) { rs_for_units(T_, FF, false, SS, RS);
                  run_gemm(lds, XB, (const bf16_t*)(ws + WS_WM1 + 8 * MiB), T_, FF, DM, pg8::EpiB<1, false, 1>{BIG, FF, nullptr, 0, 0, RS, nullptr, -1}); SEAM(13); }
    if (IN(14)) { run_gemm(lds, BIG, (const bf16_t*)(ws + WS_WM2 + 8 * MiB), T_, DM, FF, pg8::EpiRb<false>{XB, DM, nullptr}); SEAM(14); }
    if (IN(15)) { final_rows(XB, p.in[3], p.out, gw, ngw, lane); }
#undef IN
#undef RSTD_PASS
#undef SEAM
}

#ifndef MK_PER_PHASE
#define MK_PER_PHASE 0
#endif
extern "C" void kernel_launch(void* const* d_in, const int* in_sizes, int n_in, void* d_out, int out_size, void* d_ws, size_t ws_size, hipStream_t stream) {
    static int grid = 0;
    if (grid == 0) {
        int dev = 0, cus = 0, per_cu = 0;
        (void)hipGetDevice(&dev);
        (void)hipDeviceGetAttribute(&cus, hipDeviceAttributeMultiprocessorCount, dev);
        if (hipFuncSetAttribute((const void*)trunk_fwd, hipFuncAttributeMaxDynamicSharedMemorySize, LDS_BYTES) != hipSuccess) fprintf(stderr, "kernel_launch: hipFuncSetAttribute failed\n");
        if (hipOccupancyMaxActiveBlocksPerMultiprocessor(&per_cu, (const void*)trunk_fwd, 512, LDS_BYTES) != hipSuccess || per_cu < 1) { fprintf(stderr, "kernel_launch: occupancy query says %d\n", per_cu); per_cu = 1; }
        (void)hipGetLastError();
        grid = cus * 1;
        if (n_in != 21 || ws_size < WS_END) fprintf(stderr, "kernel_launch: unexpected n_in %d / ws %zu\n", n_in, ws_size);
    }
    (void)hipMemsetAsync((unsigned char*)d_ws + WS_BAR, 0, (XCD_BAR_WORDS + 64) * sizeof(unsigned), stream);
    Params p{};
    for (int i = 0; i < 21; ++i) p.in[i] = (const float*)d_in[i];
    p.out = (float*)d_out; p.ws = (unsigned char*)d_ws;
#if MK_PER_PHASE
    for (int ph = 0; ph < NPHASE; ++ph) { p.ph_lo = ph; p.ph_hi = ph + 1; hipLaunchKernelGGL(trunk_fwd, dim3(grid), dim3(512), LDS_BYTES, stream, p); }
#else
    p.ph_lo = 0; p.ph_hi = NPHASE;
    void* args[] = {&p};
    hipError_t e = hipLaunchCooperativeKernel((const void*)trunk_fwd, dim3(grid), dim3(512), args, LDS_BYTES, stream);
    if (e != hipSuccess) fprintf(stderr, "kernel_launch: cooperative launch failed: %s (grid %d)\n", hipGetErrorString(e), grid);
#endif
}
```

```cpp
#define PROBE_DUP 0
#include <hip/hip_runtime.h>
#include <hip/hip_cooperative_groups.h>
#include <cstdio>
#include <cstdint>
namespace cg = cooperative_groups;
namespace pg8 {
#define PG8_LAS __attribute__((address_space(3)))
typedef unsigned short bf16_t;
typedef short bf16x8 __attribute__((ext_vector_type(8)));
typedef float f32x4 __attribute__((ext_vector_type(4)));
typedef unsigned u32x4 __attribute__((ext_vector_type(4)));
constexpr int BM = 256, BK = 64, HALF = 128, HTB = HALF * BK * 2  , STAGE_BYTES = 8 * HTB, NXCD = 8, WGM = 4;

__host__ __device__ __forceinline__ int lds_byte(int r, int c) { const int st = (r >> 4) * 2 + (c >> 5), rr = r & 15, cc = c & 31, ob = rr * 64 + cc * 2; return st * 1024 + (ob ^ (((ob >> 9) & 1) << 5)); }
__host__ __device__ __forceinline__ void stage_rc(int b, int& R, int& C) { const int st = b / 1024, sb = b % 1024, swz = sb ^ (((sb >> 9) & 1) << 5); R = (st >> 1) * 16 + swz / 64; C = (st & 1) * 32 + (swz % 64) / 2; }
__host__ __device__ __forceinline__ int perm32(int rho) { const int n = rho >> 4, i = rho & 15; return 8 * (i >> 2) + 4 * n + (i & 3); }

struct Unit { int pm, pn; };
struct Gemm { const bf16_t* A; const bf16_t* Bt; int M, N, K; };

struct StaticOrder {
    int nM, nN, nwg, G, c;
    __host__ __device__ void init(int M, int N, int G_, int c_) { nM = M / BM; nN = N / BM; nwg = nM * nN; G = G_; c = c_; }
    __host__ __device__ bool next(int i, Unit& u) const {
        const long L = (long)i * G + c; if (L >= nwg) return false;
        int wgid = (int)L; { const int q = nwg / NXCD, r = nwg % NXCD, xcd = wgid % NXCD, off = wgid / NXCD; wgid = (xcd < r ? xcd * (q + 1) : r * (q + 1) + (xcd - r) * q) + off; }
        const int nig = WGM * nN, gid = wgid / nig, fm = gid * WGM, gsz = (nM - fm) < WGM ? (nM - fm) : WGM;
        u.pm = fm + ((wgid % nig) % gsz); u.pn = (wgid % nig) / gsz; return true;
    }
    __device__ __forceinline__ void a_ready(const Unit&) const {}
    __device__ __forceinline__ void done(const Unit&) const {}
};

__device__ __forceinline__ unsigned cvt_pk_bf16(float lo, float hi) { unsigned r; asm volatile("v_cvt_pk_bf16_f32 %0, %1, %2" : "=v"(r) : "v"(lo), "v"(hi)); return r; }

template <class Epi, class Sched, bool ALIGN_EPI = false, bool SP2 = false>
__device__ __forceinline__ void gemm_phase(PG8_LAS unsigned char* lds, const Gemm g, const Sched& S, const Epi& E) {
    const int tid = threadIdx.x, wid = __builtin_amdgcn_readfirstlane(tid >> 6), lane = tid & 63, wr = wid >> 2, wc = wid & 3, fr = lane & 15, fq = lane >> 4;
    const int K = g.K, nt = K / BK;
    unsigned voffA[2], voffB[2];
#pragma unroll
    for (int i = 0; i < 2; ++i) { int R, C; stage_rc(tid * 16 + i * 8192, R, C); const int Rb = Epi::PERM ? ((R & ~31) + perm32(R & 31)) : R;
        voffA[i] = (unsigned)(R * K + C) * 2u; voffB[i] = (unsigned)(Rb * K + C) * 2u; }
    const size_t kstep = (size_t)(BK * 2);
    const size_t hstep = (size_t)HALF * K * 2;
    const size_t tstep = 2 * hstep;
    const unsigned ldsw = (unsigned)wid * 1024u;
    const int aoff = lds_byte(wr * 64 + fr, fq * 8), boff = lds_byte(wc * 32 + fr, fq * 8);
#define PG8_SA(b, h) (((b) * 2 + (h)) * HTB)
#define PG8_SB(b, h) ((4 + (b) * 2 + (h)) * HTB)
#define PG8_STAGE(bufoff, gbase, voff) do { _Pragma("unroll") for (int _i = 0; _i < 2; ++_i) \
        __builtin_amdgcn_global_load_lds((const unsigned*)((const char*)(gbase) + (voff)[_i]), (PG8_LAS unsigned*)(lds + (bufoff) + ldsw + _i * 8192), 16, 0, 0); } while (0)
#define PG8_LDA(dst, b, h) do { _Pragma("unroll") for (int m = 0; m < 4; ++m) _Pragma("unroll") for (int k = 0; k < 2; ++k) dst[m][k] = *(const PG8_LAS bf16x8*)(lds + PG8_SA(b, h) + aoff + m * 2048 + k * 1024); } while (0)
#define PG8_LDB(dst, b, h) do { _Pragma("unroll") for (int n = 0; n < 2; ++n) _Pragma("unroll") for (int k = 0; k < 2; ++k) dst[n][k] = *(const PG8_LAS bf16x8*)(lds + PG8_SB(b, h) + boff + n * 2048 + k * 1024); } while (0)
#define PG8_MMA(ai, bj, At, Bt) do { __builtin_amdgcn_s_setprio(1); _Pragma("unroll") for (int m = 0; m < 4; ++m) _Pragma("unroll") for (int n = 0; n < 2; ++n) _Pragma("unroll") for (int k = 0; k < 2; ++k) \
        acc[ai][bj][m][n] = __builtin_amdgcn_mfma_f32_16x16x32_bf16(Bt[n][k], At[m][k], acc[ai][bj][m][n], 0, 0, 0); __builtin_amdgcn_s_setprio(0); } while (0)
#define PG8_WAIT_V(n) asm volatile("s_waitcnt vmcnt(" #n ")" ::: "memory")
#define PG8_WAIT_L(n) asm volatile("s_waitcnt lgkmcnt(" #n ")" ::: "memory")
#define PG8_BAR __builtin_amdgcn_s_barrier()
#define PG8_SCHED __builtin_amdgcn_sched_barrier(0)
    Unit cur, nxt; int ui = 0;
    if (!S.next(0, cur)) return;
    f32x4 acc[2][2][4][2];
#pragma unroll
    for (int a = 0; a < 2; ++a)
#pragma unroll
        for (int b = 0; b < 2; ++b)
#pragma unroll
            for (int m = 0; m < 4; ++m)
#pragma unroll
                for (int n = 0; n < 2; ++n) acc[a][b][m][n] = (f32x4){0.f, 0.f, 0.f, 0.f};
    bf16x8 At[4][2], B0[2][2], B1[2][2];
    const char* cA = (const char*)g.A + (size_t)cur.pm * tstep; const char* cB = (const char*)g.Bt + (size_t)cur.pn * tstep;
    S.a_ready(cur);
    if constexpr (SP2) {
        PG8_STAGE(PG8_SB(0, 0), cB, voffB); PG8_STAGE(PG8_SB(0, 1), cB + hstep, voffB); PG8_STAGE(PG8_SA(0, 0), cA, voffA); PG8_STAGE(PG8_SA(0, 1), cA + hstep, voffA);
        if (wr == 1) PG8_BAR;
        PG8_WAIT_V(2); PG8_BAR;
        PG8_STAGE(PG8_SB(1, 0), cB + kstep, voffB); PG8_STAGE(PG8_SA(1, 0), cA + kstep, voffA); PG8_STAGE(PG8_SB(1, 1), cB + hstep + kstep, voffB);
        PG8_WAIT_V(6); PG8_BAR;
    } else {
        PG8_STAGE(PG8_SB(0, 0), cB, voffB); PG8_STAGE(PG8_SA(0, 0), cA, voffA); PG8_STAGE(PG8_SB(0, 1), cB + hstep, voffB); PG8_STAGE(PG8_SA(0, 1), cA + hstep, voffA);
        if (wr == 1) PG8_BAR;
        PG8_WAIT_V(4); PG8_BAR;
        PG8_STAGE(PG8_SB(1, 0), cB + kstep, voffB); PG8_STAGE(PG8_SA(1, 0), cA + kstep, voffA); PG8_STAGE(PG8_SB(1, 1), cB + hstep + kstep, voffB);
        PG8_WAIT_V(6); PG8_BAR;
    }
    for (;;) {
        const bool has_next = S.next(ui + 1, nxt);
        const char* nA = has_next ? (const char*)g.A + (size_t)nxt.pm * tstep : cA; const char* nB = has_next ? (const char*)g.Bt + (size_t)nxt.pn * tstep : cB;
        for (int t = 0; t < nt; t += 2) {
            const bool last = (t == nt - 2);
            const char* a1 = cA + (size_t)(t + 1) * kstep;
            const char* a2 = last ? nA : cA + (size_t)(t + 2) * kstep; const char* b2 = last ? nB : cB + (size_t)(t + 2) * kstep;
            const char* a3 = a2 + kstep; const char* b3 = b2 + kstep;
            if (last && has_next) S.a_ready(nxt);
            if constexpr (SP2) {
            PG8_LDB(B0, 0, 0); PG8_LDB(B1, 0, 1); PG8_SCHED; PG8_LDA(At, 0, 0); PG8_STAGE(PG8_SA(1, 1), a1 + hstep, voffA);
            PG8_WAIT_V(8); PG8_WAIT_L(0); PG8_BAR; PG8_MMA(0, 0, At, B0); PG8_MMA(0, 1, At, B1); PG8_BAR; PG8_SCHED;
            PG8_LDA(At, 0, 1); PG8_STAGE(PG8_SB(0, 0), b2, voffB); PG8_STAGE(PG8_SB(0, 1), b2 + hstep, voffB); PG8_STAGE(PG8_SA(0, 0), a2, voffA);
            PG8_WAIT_V(8); PG8_WAIT_L(0); PG8_BAR; PG8_MMA(1, 0, At, B0); PG8_MMA(1, 1, At, B1); PG8_BAR; PG8_SCHED;
            PG8_LDB(B0, 1, 0); PG8_LDB(B1, 1, 1); PG8_SCHED; PG8_LDA(At, 1, 0); PG8_STAGE(PG8_SA(0, 1), a2 + hstep, voffA);
            PG8_WAIT_V(8); PG8_WAIT_L(0); PG8_BAR; PG8_MMA(0, 0, At, B0); PG8_MMA(0, 1, At, B1); PG8_BAR; PG8_SCHED;
            PG8_LDA(At, 1, 1); PG8_STAGE(PG8_SB(1, 0), b3, voffB); PG8_STAGE(PG8_SB(1, 1), b3 + hstep, voffB); PG8_STAGE(PG8_SA(1, 0), a3, voffA);
            PG8_WAIT_V(8); PG8_WAIT_L(0); PG8_BAR; PG8_MMA(1, 0, At, B0); PG8_MMA(1, 1, At, B1); PG8_BAR; PG8_SCHED;
            } else {
            PG8_LDB(B0, 0, 0); PG8_SCHED; PG8_LDA(At, 0, 0); PG8_STAGE(PG8_SA(1, 1), a1 + hstep, voffA);
            PG8_WAIT_L(8); PG8_BAR; PG8_WAIT_L(0); PG8_MMA(0, 0, At, B0); PG8_BAR; PG8_SCHED;
            PG8_LDB(B1, 0, 1); PG8_STAGE(PG8_SB(0, 0), b2, voffB);
            PG8_BAR; PG8_WAIT_L(0); PG8_MMA(0, 1, At, B1); PG8_BAR;
            PG8_LDA(At, 0, 1); PG8_STAGE(PG8_SA(0, 0), a2, voffA);
            PG8_BAR; PG8_WAIT_L(0); PG8_MMA(1, 0, At, B0); PG8_BAR; PG8_SCHED;
            PG8_STAGE(PG8_SB(0, 1), b2 + hstep, voffB);
            PG8_WAIT_V(6); PG8_BAR; PG8_MMA(1, 1, At, B1); PG8_BAR;
            PG8_LDB(B0, 1, 0); PG8_SCHED; PG8_LDA(At, 1, 0); PG8_STAGE(PG8_SA(0, 1), a2 + hstep, voffA);
            PG8_WAIT_L(8); PG8_BAR; PG8_WAIT_L(0); PG8_MMA(0, 0, At, B0); PG8_BAR; PG8_SCHED;
            PG8_LDB(B1, 1, 1); PG8_STAGE(PG8_SB(1, 0), b3, voffB);
            PG8_BAR; PG8_WAIT_L(0); PG8_MMA(0, 1, At, B1); PG8_BAR;
            PG8_LDA(At, 1, 1); PG8_STAGE(PG8_SA(1, 0), a3, voffA);
            PG8_BAR; PG8_WAIT_L(0); PG8_MMA(1, 0, At, B0); PG8_BAR; PG8_SCHED;
            PG8_STAGE(PG8_SB(1, 1), b3 + hstep, voffB);
            PG8_WAIT_V(6); PG8_BAR; PG8_MMA(1, 1, At, B1); PG8_BAR;
            }
        }
        if constexpr (ALIGN_EPI) { if (wr == 0) PG8_BAR; }
        if constexpr (!Epi::AFTER_DRAIN) { E(acc, cur, wr, wc, fr, fq); S.done(cur); }
        if (!has_next) break;
#pragma unroll
        for (int a = 0; a < 2; ++a)
#pragma unroll
            for (int b = 0; b < 2; ++b)
#pragma unroll
                for (int m = 0; m < 4; ++m)
#pragma unroll
                    for (int n = 0; n < 2; ++n) acc[a][b][m][n] = (f32x4){0.f, 0.f, 0.f, 0.f};
        cur = nxt; cA = nA; cB = nB; ++ui;
        if constexpr (ALIGN_EPI) { if (wr == 1) PG8_BAR; }
    }
    PG8_WAIT_V(0);
    if constexpr (!ALIGN_EPI) { if (wr == 0) PG8_BAR; }
    PG8_BAR;
    if constexpr (Epi::AFTER_DRAIN) { E.fused(acc, cur, wr, wc, fr, fq, lds, wid, lane); S.done(cur); }
#undef PG8_SA
#undef PG8_SB
#undef PG8_STAGE
#undef PG8_LDA
#undef PG8_LDB
#undef PG8_MMA
#undef PG8_WAIT_V
#undef PG8_WAIT_L
#undef PG8_BAR
#undef PG8_SCHED
}
}
namespace pg8 {
typedef unsigned u32x2 __attribute__((ext_vector_type(2)));
__device__ __forceinline__ unsigned pkbf(float a, float b) { typedef float f2 __attribute__((ext_vector_type(2))); typedef __bf16 b2 __attribute__((ext_vector_type(2)));
    f2 v = {a, b}; b2 r = __builtin_convertvector(v, b2); return __builtin_bit_cast(unsigned, r); }
template <int ACT  , bool KMAX = false, int SCALE = 0, bool TILED = false  > struct EpiB {
    static constexpr bool PERM = true, AFTER_DRAIN = false;
    bf16_t* O; int ldc; unsigned* kmax; int kpn0, kpn1; const float* ss; bf16_t* kfrag; int kfpn;
    __device__ __forceinline__ void operator()(const f32x4 (&acc)[2][2][4][2], const Unit& u, int wr, int wc, int fr, int fq) const {
        const int row0 = u.pm * BM + wr * 64 + fr; const int col0 = u.pn * BM + wc * 32 + 8 * fq;
        float rsr[2][4]; f32x4 rsc[2][2];
        if (SCALE == 1) {
#pragma unroll
            for (int ai = 0; ai < 2; ++ai)
#pragma unroll
                for (int m = 0; m < 4; ++m) rsr[ai][m] = ss[row0 + ai * HALF + m * 16]; }
        if (SCALE == 2) {
#pragma unroll
            for (int bj = 0; bj < 2; ++bj)
#pragma unroll
                for (int n = 0; n < 2; ++n) rsc[bj][n] = *(const f32x4*)(ss + col0 + bj * HALF + 4 * n); }
        if (KMAX) if (u.pn >= kpn0 && u.pn < kpn1) {
#pragma unroll
            for (int bj = 0; bj < 2; ++bj) { float mx = 0.f;
#pragma unroll
                for (int ai = 0; ai < 2; ++ai)
#pragma unroll
                    for (int m = 0; m < 4; ++m) { const f32x4 a = acc[ai][bj][m][0], b = acc[ai][bj][m][1];
                        float q = (a[0] * a[0] + a[1] * a[1]) + (a[2] * a[2] + a[3] * a[3]) + (b[0] * b[0] + b[1] * b[1]) + (b[2] * b[2] + b[3] * b[3]);
                        if (SCALE == 1) q *= rsr[ai][m] * rsr[ai][m];
                        q += __shfl_xor(q, 16); q += __shfl_xor(q, 32); mx = fmaxf(mx, q); }
                mx = fmaxf(mx, __shfl_xor(mx, 1)); mx = fmaxf(mx, __shfl_xor(mx, 2)); mx = fmaxf(mx, __shfl_xor(mx, 4)); mx = fmaxf(mx, __shfl_xor(mx, 8));
                if (fr == 0 && fq == 0) atomicMax(kmax + (u.pm >> 5) * ((kpn1 - kpn0) * 8) + (u.pn - kpn0) * 8 + bj * 4 + wc, __float_as_uint(mx)); }
        }
#pragma unroll
        for (int ai = 0; ai < 2; ++ai)
#pragma unroll
            for (int m = 0; m < 4; ++m) { bf16_t* rowp = O + (size_t)(row0 + ai * HALF + m * 16) * ldc + col0;
#pragma unroll
                for (int bj = 0; bj < 2; ++bj) { f32x4 v0 = acc[ai][bj][m][0], v1 = acc[ai][bj][m][1];
                    if (SCALE == 1) { v0 *= rsr[ai][m]; v1 *= rsr[ai][m]; }
                    if (SCALE == 2) { v0 *= rsc[bj][0]; v1 *= rsc[bj][1]; }
                    if (ACT == 1) {
#pragma unroll
                        for (int e = 0; e < 4; ++e) { float a = fmaxf(v0[e], 0.f), b = fmaxf(v1[e], 0.f); v0[e] = a * a; v1[e] = b * b; } }
                    u32x4 w; w.x = pkbf(v0[0], v0[1]); w.y = pkbf(v0[2], v0[3]); w.z = pkbf(v1[0], v1[1]); w.w = pkbf(v1[2], v1[3]);
                    if (TILED) { const int f = row0 + ai * HALF + m * 16, tok = col0 + bj * HALF, d = f & 63, q = (tok & 31) >> 3;
                        *(u32x4*)(O + ((size_t)((f >> 6) * 1024 + (tok >> 5)) * 2048) + (((((d >> 5) * 2 + (q >> 1)) * 2 + (q & 1)) * 32 + (d & 31)) * 8)) = w; }
                    else if (kfrag != nullptr && u.pn == kfpn) { const int tok = row0 + ai * HALF + m * 16, cc = wc * 32 + 8 * fq + bj * HALF, d0 = cc & 63, ky = tok & 31;
                        const int rho = 16 * (ky >> 4) + 8 * ((ky >> 2) & 1) + 4 * ((ky >> 3) & 1) + (ky & 3);
                        *(u32x4*)(kfrag + ((size_t)((cc >> 6) * 1024 + (tok >> 5)) * 2048) + (((d0 >> 4) * 64 + ((d0 >> 3) & 1) * 32 + rho) * 8)) = w; }
                    else *(u32x4*)(rowp + bj * HALF) = w; } }
    }
};
template <bool NORM> struct EpiR {
    static constexpr bool PERM = false, AFTER_DRAIN = false;
    const float* base; float* out; int ldc; bf16_t* xb; float* ss;
    __device__ __forceinline__ void operator()(const f32x4 (&acc)[2][2][4][2], const Unit& u, int wr, int wc, int fr, int fq) const {
        const int col0 = u.pn * BM + wc * 32 + 4 * fq;
#pragma unroll
        for (int ai = 0; ai < 2; ++ai)
#pragma unroll
            for (int m = 0; m < 4; ++m) { const int r = ai * HALF + wr * 64 + m * 16 + fr; const size_t off = (size_t)(u.pm * BM + r) * ldc + col0; float q = 0.f;
#pragma unroll
                for (int bj = 0; bj < 2; ++bj)
#pragma unroll
                    for (int n = 0; n < 2; ++n) { const f32x4 bs = *(const f32x4*)(base + off + bj * HALF + n * 16); const f32x4 o = bs + acc[ai][bj][m][n]; *(f32x4*)(out + off + bj * HALF + n * 16) = o;
                        if (NORM) { q += (o[0] * o[0] + o[1] * o[1]) + (o[2] * o[2] + o[3] * o[3]); u32x2 w; w.x = pkbf(o[0], o[1]); w.y = pkbf(o[2], o[3]); *(u32x2*)(xb + off + bj * HALF + n * 16) = w; } }
                if (NORM) { q += __shfl_xor(q, 16); q += __shfl_xor(q, 32); if (fq == 0) ss[(size_t)(u.pm * BM + r) * 16 + u.pn * 4 + wc] = q; } }
    }
};
template <bool NORM> struct EpiRb {
    static constexpr bool PERM = true, AFTER_DRAIN = false;
    bf16_t* xb; int ldc; float* ss;
    __device__ __forceinline__ void operator()(const f32x4 (&acc)[2][2][4][2], const Unit& u, int wr, int wc, int fr, int fq) const {
        const int col0 = u.pn * BM + wc * 32 + 8 * fq;
#pragma unroll
        for (int ai = 0; ai < 2; ++ai)
#pragma unroll
            for (int m = 0; m < 4; ++m) { const int r = ai * HALF + wr * 64 + m * 16 + fr; bf16_t* rowp = xb + (size_t)(u.pm * BM + r) * ldc + col0; float q = 0.f;
                u32x4 bw[2];
#pragma unroll
                for (int bj = 0; bj < 2; ++bj) bw[bj] = *(const u32x4*)(rowp + bj * HALF);
#pragma unroll
                for (int bj = 0; bj < 2; ++bj) { const u32x4 b = bw[bj]; const f32x4 a0 = acc[ai][bj][m][0], a1 = acc[ai][bj][m][1];
                    u32x4 w;
                    w.x = pkbf(__uint_as_float(b.x << 16) + a0[0], __uint_as_float(b.x & 0xffff0000u) + a0[1]);
                    w.y = pkbf(__uint_as_float(b.y << 16) + a0[2], __uint_as_float(b.y & 0xffff0000u) + a0[3]);
                    w.z = pkbf(__uint_as_float(b.z << 16) + a1[0], __uint_as_float(b.z & 0xffff0000u) + a1[1]);
                    w.w = pkbf(__uint_as_float(b.w << 16) + a1[2], __uint_as_float(b.w & 0xffff0000u) + a1[3]);
                    *(u32x4*)(rowp + bj * HALF) = w;
                    if (NORM) {
#pragma unroll
                        for (int e = 0; e < 4; ++e) { const float lo = __uint_as_float(w[e] << 16), hi = __uint_as_float(w[e] & 0xffff0000u); q += lo * lo + hi * hi; } } }
                if (NORM) { q += __shfl_xor(q, 16); q += __shfl_xor(q, 32); if (fq == 0) ss[(size_t)(u.pm * BM + r) * 16 + u.pn * 4 + wc] = q; } }
    }
};
}

#define DI __device__ __forceinline__
typedef unsigned short bf16_t;
typedef short bf16x8 __attribute__((ext_vector_type(8)));
typedef float f32x16 __attribute__((ext_vector_type(16)));
typedef float f32x4 __attribute__((ext_vector_type(4)));
typedef unsigned u32x4 __attribute__((ext_vector_type(4)));
typedef unsigned u32x2 __attribute__((ext_vector_type(2)));
#define MFMA32(a, b, c) __builtin_amdgcn_mfma_f32_32x32x16_bf16((a), (b), (c), 0, 0, 0)
constexpr int T_ = 32768, S_ = 8192, NBAT = 4, DM = 1024, FF = 4096;
constexpr int LDP0 = 2048, LDP1 = 2304;
constexpr float LOG2E = 1.4426950408889634f, LN2 = 0.6931471805599453f;
constexpr float C1 = 0.125f * LOG2E;
constexpr float RMS_EPS = 1e-6f;
constexpr size_t MiB = 1024 * 1024;
constexpr size_t WS_W0QK = 0, WS_W0V = 4 * MiB, WS_W0O = 6 * MiB, WS_W1A = 8 * MiB, WS_W1V = 8 * MiB + 4608 * 1024, WS_W1O = WS_W1V + 1 * MiB,
                 WS_WM1 = WS_W1O + 2 * MiB, WS_WM2 = WS_WM1 + 16 * MiB, WS_WC1 = WS_WM2 + 16 * MiB, WS_WC2 = WS_WC1 + 2 * MiB, WS_BIAS = WS_WC2 + 64 * 1024,
                 WS_KC = 50 * MiB, WS_VCT = 51 * MiB, WS_XN = 52 * MiB, WS_BIG = 116 * MiB, WS_VT = WS_BIG + 160 * MiB, WS_XB = WS_BIG + 256 * MiB, WS_SS = WS_XB + 64 * MiB, WS_RS = WS_SS + 2 * MiB, WS_KSF = WS_RS + 1 * MiB, WS_END = WS_KSF + 16 * MiB;
static_assert(WS_BIAS + 4096 <= 50 * MiB - 20480, "ws map");
constexpr int LDS_GEMM = 131072;
constexpr int LDS_BYTES = LDS_GEMM + 16;
constexpr size_t WS_BAR = 50 * MiB - 16384;
constexpr size_t WS_QCTR = WS_BAR + 13824;
constexpr size_t WS_KMX = 50 * MiB - 20480;
constexpr int WAVE_LDS = 8704;

struct Params { const float* in[21]; float* out; unsigned char* ws; int ph_lo, ph_hi; };

DI unsigned pk2(float a, float b) { return pg8::pkbf(a, b); }
DI bf16x8 ldg8(const bf16_t* p) { return *(const bf16x8*)p; }
DI float fexp2(float x) { return __builtin_amdgcn_exp2f(x); }
DI float flog2(float x) { return __builtin_amdgcn_logf(x); }
DI float bf2f(bf16_t v) { return __uint_as_float((unsigned)v << 16); }
DI bf16x8 pack8(float a0, float a1, float a2, float a3, float a4, float a5, float a6, float a7) {
    u32x4 p; p.x = pk2(a0, a1); p.y = pk2(a2, a3); p.z = pk2(a4, a5); p.w = pk2(a6, a7); return __builtin_bit_cast(bf16x8, p); }
DI void wave_lds_sync() { asm volatile("s_waitcnt lgkmcnt(0)" ::: "memory"); }
DI float wave_sum(float v) {
#pragma unroll
    for (int o = 1; o < 64; o <<= 1) v += __shfl_xor(v, o);
    return v; }
DI f32x16 zero16() { f32x16 z;
#pragma unroll
    for (int i = 0; i < 16; ++i) z[i] = 0.f;
    return z; }
DI int vfrag_off(int d, int ch) { return ((((d >> 5) * 2 + (ch >> 1)) * 2 + (ch & 1)) * 32 + (d & 31)) * 8; }
DI int krow_of(int r) { return 16 * (r >> 4) + 8 * ((r >> 2) & 1) + 4 * ((r >> 3) & 1) + (r & 3); }

DI void transpose_item(const float* W, int K, int N, int c0, int nc, bf16_t* WT, int r0, int item, float* scr, int lane, const float* gain, bool frag) {
    const int nblk = nc >> 5, kb = item / nblk, nb = item - kb * nblk, k0 = 64 * kb, n0 = 32 * nb;
    const int col = c0 + n0 + (lane & 31); const bool ok = col < N;
    const float* src = W + (size_t)(k0 + (lane >> 5)) * N + (ok ? col : c0);
    float v[32];
#pragma unroll
    for (int i = 0; i < 32; ++i) v[i] = src[(size_t)(2 * i) * N];
    if (gain) {
        float gv[32];
#pragma unroll
        for (int i = 0; i < 32; ++i) gv[i] = gain[k0 + 2 * i + (lane >> 5)];
#pragma unroll
        for (int i = 0; i < 32; ++i) v[i] *= gv[i];
    }
#pragma unroll
    for (int i = 0; i < 32; ++i) scr[(2 * i + (lane >> 5)) * 33 + (lane & 31)] = ok ? v[i] : 0.f;
    wave_lds_sync();
    const int c = lane & 7;
#pragma unroll
    for (int j = 0; j < 4; ++j) { const int n = (lane >> 3) + 8 * j; const float* s = scr + (8 * c) * 33 + n;
        u32x4 o; o.x = pk2(s[0 * 33], s[1 * 33]); o.y = pk2(s[2 * 33], s[3 * 33]); o.z = pk2(s[4 * 33], s[5 * 33]); o.w = pk2(s[6 * 33], s[7 * 33]);
        if (frag) { const int nn = r0 + n0 + n, k = k0 + 8 * c;
            *(u32x4*)(WT + ((size_t)((k >> 4) * 8 + (nn >> 5)) * 64 + ((k >> 3) & 1) * 32 + (nn & 31)) * 8) = o; }
        else *(u32x4*)(WT + (size_t)(r0 + n0 + n) * K + k0 + 8 * c) = o; }
    wave_lds_sync();
}
struct Seg { const float* W; int K, N, c0, nc, r0; bf16_t* dst; };
DI Seg get_seg(const Params& p, int s) {
    unsigned char* ws = p.ws; Seg g;
    switch (s) {
    case 0:  g = Seg{p.in[4], 1024, 3072, 0, 1024, 0, (bf16_t*)(ws + WS_W0QK)}; break;
    case 1:  g = Seg{p.in[4], 1024, 3072, 1536, 1024, 1024, (bf16_t*)(ws + WS_W0QK)}; break;
    case 2:  g = Seg{p.in[4], 1024, 3072, 1024, 512, 0, (bf16_t*)(ws + WS_W0V)}; break;
    case 3:  g = Seg{p.in[4], 1024, 3072, 2560, 512, 512, (bf16_t*)(ws + WS_W0V)}; break;
    case 4:  g = Seg{p.in[10], 1024, 1024, 0, 1024, 0, (bf16_t*)(ws + WS_W0O)}; break;
    case 5:  g = Seg{p.in[11], 1024, 2608, 0, 1536, 0, (bf16_t*)(ws + WS_W1A)}; break;
    case 6:  g = Seg{p.in[11], 1024, 2608, 1536, 256, 1536, (bf16_t*)(ws + WS_W1A)}; break;
    case 7:  g = Seg{p.in[11], 1024, 2608, 2048, 256, 1792, (bf16_t*)(ws + WS_W1A)}; break;
    case 8:  g = Seg{p.in[11], 1024, 2608, 2560, 256, 2048, (bf16_t*)(ws + WS_W1A)}; break;
    case 9:  g = Seg{p.in[11], 1024, 2608, 1792, 256, 0, (bf16_t*)(ws + WS_W1V)}; break;
    case 10: g = Seg{p.in[11], 1024, 2608, 2304, 256, 256, (bf16_t*)(ws + WS_W1V)}; break;
    case 11: g = Seg{p.in[18], 1024, 1024, 0, 1024, 0, (bf16_t*)(ws + WS_W1O)}; break;
    case 12: g = Seg{p.in[19], 1024, 4096, 0, 4096, 0, (bf16_t*)(ws + WS_WM1)}; break;
    case 13: g = Seg{p.in[19] + (size_t)1024 * 4096, 1024, 4096, 0, 4096, 0, (bf16_t*)(ws + WS_WM1 + 8 * MiB)}; break;
    case 14: g = Seg{p.in[20], 4096, 1024, 0, 1024, 0, (bf16_t*)(ws + WS_WM2)}; break;
    case 15: g = Seg{p.in[20] + (size_t)1024 * 4096, 4096, 1024, 0, 1024, 0, (bf16_t*)(ws + WS_WM2 + 8 * MiB)}; break;
    case 16: g = Seg{p.in[13], 2048, 256, 0, 256, 0, (bf16_t*)(ws + WS_WC1)}; break;
    case 17: g = Seg{p.in[16], 2048, 256, 0, 256, 0, (bf16_t*)(ws + WS_WC1 + 1 * MiB)}; break;
    case 18: g = Seg{p.in[14], 256, 64, 0, 64, 0, (bf16_t*)(ws + WS_WC2)}; break;
    default: g = Seg{p.in[17], 256, 64, 0, 64, 0, (bf16_t*)(ws + WS_WC2 + 32 * 1024)}; break;
    }
    return g;
}
constexpr int NSEG = 20;
DI void rms_rows(const float* X, const float* g, bf16_t* obf, float* of32, int gw, int ngw, int lane) {
    f32x4 gv[4];
#pragma unroll
    for (int j = 0; j < 4; ++j) gv[j] = ((const f32x4*)g)[lane + 64 * j];
    for (int row = gw * 2; row < T_; row += ngw * 2) {
        const f32x4* xr = (const f32x4*)(X + (size_t)row * DM) + lane;
        f32x4 v[2][4]; float rstd[2];
#pragma unroll
        for (int q = 0; q < 2; ++q)
#pragma unroll
            for (int j = 0; j < 4; ++j) v[q][j] = xr[q * 256 + 64 * j];
#pragma unroll
        for (int q = 0; q < 2; ++q) { float ss = 0.f;
#pragma unroll
            for (int j = 0; j < 4; ++j) ss += (v[q][j].x * v[q][j].x + v[q][j].y * v[q][j].y) + (v[q][j].z * v[q][j].z + v[q][j].w * v[q][j].w);
            rstd[q] = rsqrtf(wave_sum(ss) * (1.f / DM) + RMS_EPS); }
#pragma unroll
        for (int q = 0; q < 2; ++q)
#pragma unroll
            for (int j = 0; j < 4; ++j) {
                const f32x4 y = v[q][j] * rstd[q] * gv[j];
                if (obf) { u32x2 w; w.x = pk2(y.x, y.y); w.y = pk2(y.z, y.w); *((u32x2*)(obf + (size_t)(row + q) * DM) + lane + 64 * j) = w; }
                if (of32) ((f32x4*)(of32 + (size_t)(row + q) * DM))[lane + 64 * j] = y;
            }
    }
}
DI void final_rows(const bf16_t* X, const float* g, float* out, int gw, int ngw, int lane) {
    f32x4 gv[4];
#pragma unroll
    for (int j = 0; j < 4; ++j) gv[j] = ((const f32x4*)g)[lane + 64 * j];
    for (int row = gw * 4; row < T_; row += ngw * 4) {
        u32x2 bw[4][4]; float rstd[4];
#pragma unroll
        for (int q = 0; q < 4; ++q)
#pragma unroll
            for (int j = 0; j < 4; ++j) bw[q][j] = *((const u32x2*)(X + (size_t)(row + q) * DM) + lane + 64 * j);
#pragma unroll
        for (int q = 0; q < 4; ++q) { float ss = 0.f;
#pragma unroll
            for (int j = 0; j < 4; ++j) { const float a = __uint_as_float(bw[q][j].x << 16), b = __uint_as_float(bw[q][j].x & 0xffff0000u), c = __uint_as_float(bw[q][j].y << 16), d = __uint_as_float(bw[q][j].y & 0xffff0000u);
                ss += (a * a + b * b) + (c * c + d * d); }
            rstd[q] = rsqrtf(wave_sum(ss) * (1.f / DM) + RMS_EPS); }
#pragma unroll
        for (int q = 0; q < 4; ++q)
#pragma unroll
            for (int j = 0; j < 4; ++j) { f32x4 v; v.x = __uint_as_float(bw[q][j].x << 16); v.y = __uint_as_float(bw[q][j].x & 0xffff0000u); v.z = __uint_as_float(bw[q][j].y << 16); v.w = __uint_as_float(bw[q][j].y & 0xffff0000u);
                __builtin_nontemporal_store(v * rstd[q] * gv[j], (f32x4*)(out + (size_t)(row + q) * DM) + lane + 64 * j); }
    }
}
DI void phase_prologue(const Params& p, unsigned char* lds, int wave, int lane) {
    const int gw = blockIdx.x * 8 + wave, ngw = gridDim.x * 8;
    float* scr = (float*)(lds + wave * WAVE_LDS);
    int base = 0;
    for (int s = 0; s < NSEG; ++s) {
        const Seg g = get_seg(p, s);
        const int nit = (g.K >> 6) * (g.nc >> 5);
        int first = (gw - (base % ngw) + ngw) % ngw;
        for (int it = first; it < nit; it += ngw) transpose_item(g.W, g.K, g.N, g.c0, g.nc, g.dst, g.r0, it, scr, lane, s <= 3 ? p.in[1] : (s >= 5 && s <= 10) ? p.in[1] + DM : s == 12 ? p.in[2] : s == 13 ? p.in[2] + DM : nullptr, s == 16 || s == 17);
        base += nit;
    }
    if (blockIdx.x == 0 && wave == 0) { ((unsigned*)(p.ws + WS_KMX))[lane] = 0u; ((unsigned*)(p.ws + WS_KMX))[64 + lane] = 0u; }
    {
        bf16_t* XB = (bf16_t*)(p.ws + WS_XB); float* RSt = (float*)(p.ws + WS_RS);
        for (int row = gw * 4; row < T_; row += ngw * 4) {
            const f32x4* xr = (const f32x4*)(p.in[0] + (size_t)row * DM) + lane; f32x4 v[4][4]; float ss[4];
#pragma unroll
            for (int q = 0; q < 4; ++q)
#pragma unroll
                for (int j = 0; j < 4; ++j) v[q][j] = xr[q * 256 + 64 * j];
#pragma unroll
            for (int q = 0; q < 4; ++q) { float a = 0.f;
#pragma unroll
                for (int j = 0; j < 4; ++j) a += (v[q][j].x * v[q][j].x + v[q][j].y * v[q][j].y) + (v[q][j].z * v[q][j].z + v[q][j].w * v[q][j].w);
                ss[q] = wave_sum(a); }
#pragma unroll
            for (int q = 0; q < 4; ++q) {
#pragma unroll
                for (int j = 0; j < 4; ++j) { u32x2 w; w.x = pk2(v[q][j].x, v[q][j].y); w.y = pk2(v[q][j].z, v[q][j].w); *((u32x2*)(XB + (size_t)(row + q) * DM) + lane + 64 * j) = w; }
                if (lane == 0) RSt[row + q] = rsqrtf(ss[q] * (1.f / DM) + RMS_EPS); }
        }
    }
    for (int ob = gw; ob < 512; ob += ngw) {
        const int kv = ob >> 8, j = ob & 255; const float* pos = kv ? p.in[15] : p.in[12]; const float* w1 = kv ? p.in[16] : p.in[13];
        float a = 0.f;
        for (int i = 0; i < 32; ++i) { const int k = lane + 64 * i; a += pos[k] * w1[(size_t)k * 256 + j]; }
        a = wave_sum(a);
        if (lane == 0) ((float*)(p.ws + WS_BIAS))[ob] = a;
    }
}

DI void softmax_tile(f32x16& s, float& m, float& l, float& alpha) {
    float mt = fmaxf(fmaxf(s[0], s[1]), fmaxf(s[2], s[3]));
#pragma unroll
    for (int j = 4; j < 16; j += 4) mt = fmaxf(mt, fmaxf(fmaxf(s[j], s[j + 1]), fmaxf(s[j + 2], s[j + 3])));
    mt = fmaxf(mt, __shfl_xor(mt, 32));
    const float mn = fmaxf(m, mt); alpha = fexp2(m - mn); m = mn;
    float sum = 0.f;
#pragma unroll
    for (int j = 0; j < 16; ++j) { s[j] = fexp2(s[j] - mn); sum += s[j]; }
    l = l * alpha + sum;
}
DI bool soft_core(f32x16& s, float base, float slope2, bool boundary, int tmk8, int wlim, float& mref, bool& seen, float& l, float& alpha) {
    const float b0 = base - mref;
#pragma unroll
    for (int j = 0; j < 16; ++j) s[j] = fmaf(s[j], C1, fmaf(slope2, (float)(16 * (j >> 3) + (j & 7)), b0));
    if (boundary) {
#pragma unroll
        for (int j = 0; j < 16; ++j) { const int d = tmk8 - (16 * (j >> 3) + (j & 7)); s[j] = (d >= 0 && d < wlim) ? s[j] : -INFINITY; }
    }
    float mt = fmaxf(fmaxf(s[0], s[1]), fmaxf(s[2], s[3]));
#pragma unroll
    for (int j = 4; j < 16; j += 4) mt = fmaxf(mt, fmaxf(fmaxf(s[j], s[j + 1]), fmaxf(s[j + 2], s[j + 3])));
    mt = fmaxf(mt, __shfl_xor(mt, 32));
    const bool valid = mt > -1e30f, rebase = (mt > 8.f) || (!seen && valid);
    const bool any = __any(rebase);
    alpha = 1.f;
    if (any) {
        const float delta = rebase ? mt : 0.f;
#pragma unroll
        for (int j = 0; j < 16; ++j) s[j] -= delta;
        alpha = seen ? fexp2(-delta) : 1.f; mref += delta; l *= alpha;
    }
    seen = seen || valid;
    float sum = 0.f;
#pragma unroll
    for (int j = 0; j < 16; ++j) { s[j] = fexp2(s[j]); sum += s[j]; }
    l += sum;
    return any;
}
DI void soft_tile64(const bf16_t* ktile, const bf16_t* vtile, const bf16x8 (&qf)[4], int tmk, int wlim, bool colok, bool boundary, float slope2,
                    int lane, int hf, float& m, bool& seen, float& l, f32x16& o0, f32x16& o1) {
    const bf16_t* kr = ktile + lane * 8; const bf16_t* vr = vtile + lane * 8;
    f32x16 s = zero16();
#pragma unroll
    for (int ks = 0; ks < 4; ++ks) s = MFMA32(ldg8(kr + ks * 512), qf[ks], s);
    const bf16x8 va = ldg8(vr), vc = ldg8(vr + 512), vb = ldg8(vr + 1024), vd = ldg8(vr + 1536);
    float alpha;
    if (soft_core(s, colok ? -slope2 * (float)(tmk - 8 * hf) : -INFINITY, slope2, boundary, tmk - 8 * hf, wlim, m, seen, l, alpha)) { o0 *= alpha; o1 *= alpha; }
    const bf16x8 p0 = pack8(s[0], s[1], s[2], s[3], s[4], s[5], s[6], s[7]), p1 = pack8(s[8], s[9], s[10], s[11], s[12], s[13], s[14], s[15]);
    o0 = MFMA32(va, p0, o0); o1 = MFMA32(vb, p0, o1);
    o0 = MFMA32(vc, p1, o0); o1 = MFMA32(vd, p1, o1);
}
DI void store_o64(bf16_t* orow, const f32x16& o0, const f32x16& o1, int hf) {
#pragma unroll
    for (int q = 0; q < 4; ++q) {
        u32x2 w; w.x = pk2(o0[4 * q], o0[4 * q + 1]); w.y = pk2(o0[4 * q + 2], o0[4 * q + 3]); *(u32x2*)(orow + 8 * q + 4 * hf) = w;
        u32x2 x; x.x = pk2(o1[4 * q], o1[4 * q + 1]); x.y = pk2(o1[4 * q + 2], o1[4 * q + 3]); *(u32x2*)(orow + 32 + 8 * q + 4 * hf) = x;
    }
}

DI void sb_wave(const bf16_t* QK, const bf16_t* VT, bf16_t* O, int b, int h, int tq0, int lane) {
    const int r = lane & 31, hf = lane >> 5, krow = krow_of(r), t = tq0 + r;
    const bf16_t* qp = QK + (size_t)(b * S_ + t) * LDP0 + h * 64 + 8 * hf;
    bf16x8 qf[4];
#pragma unroll
    for (int ks = 0; ks < 4; ++ks) qf[ks] = ldg8(qp + 16 * ks);
    f32x16 o0 = zero16(), o1 = zero16();
    float R = 0.f;
    for (int kb = tq0; kb >= 0; kb -= 32) {
        const bf16_t* kr = QK + (size_t)(b * S_ + kb + krow) * LDP0 + 512 + h * 64 + 8 * hf;
        f32x16 s = zero16();
#pragma unroll
        for (int ks = 0; ks < 4; ++ks) s = MFMA32(ldg8(kr + 16 * ks), qf[ks], s);
        const int tmk = t - kb;
        f32x16 lr;
        float sumLo = 0.f, sumHi = 0.f;
#pragma unroll
        for (int j = 0; j < 16; ++j) {
            const float z = s[j] * 0.125f;
            const bool valid = (tmk - (16 * (j >> 3) + 8 * hf + (j & 7))) > 0;
            const float sp = fmaxf(z, 0.f) + flog2(1.f + fexp2(-fabsf(z) * LOG2E)) * LN2;
            lr[j] = valid ? -sp : 0.f;
            s[j] = valid ? z - sp : -INFINITY;
            if (j < 8) sumLo += lr[j]; else sumHi += lr[j];
        }
        const float pLo = __shfl_xor(sumLo, 32), pHi = __shfl_xor(sumHi, 32);
        float run = R + (hf == 0 ? pHi : 0.f);
#pragma unroll
        for (int j = 15; j >= 8; --j) { const float tl = run; run += lr[j]; s[j] = fexp2((s[j] + tl) * LOG2E); }
        run = R + sumHi + pHi + (hf == 0 ? pLo : 0.f);
#pragma unroll
        for (int j = 7; j >= 0; --j) { const float tl = run; run += lr[j]; s[j] = fexp2((s[j] + tl) * LOG2E); }
        R += (sumLo + sumHi) + (pLo + pHi);
        const bf16x8 p0 = pack8(s[0], s[1], s[2], s[3], s[4], s[5], s[6], s[7]), p1 = pack8(s[8], s[9], s[10], s[11], s[12], s[13], s[14], s[15]);
        const bf16_t* vt_ = VT + ((size_t)h * 1024 + (size_t)((b * S_ + kb) >> 5)) * 2048 + lane * 8;
        o0 = MFMA32(ldg8(vt_), p0, o0); o1 = MFMA32(ldg8(vt_ + 1024), p0, o1);
        o0 = MFMA32(ldg8(vt_ + 512), p1, o0); o1 = MFMA32(ldg8(vt_ + 1536), p1, o1);
        if (__all(R < -110.f)) break;
    }
    store_o64(O + (size_t)(b * S_ + t) * DM + h * 64, o0, o1, hf);
}

constexpr int DF_KB = 32 * 144, DF_VOFF = 2 * DF_KB, DF_BUF = DF_VOFF + 128 * 80, DF_STEP = 2 * DF_BUF  , DF_FLAGS = 2 * DF_STEP, DF_QIDX = DF_FLAGS + 64, DF_X = 0  ;
DI void diff_block(const bf16_t* QK, const bf16_t* VT, bf16_t* O, const float* subln, const unsigned* kmx, float lam, int b, int h, int tqb, int wave, int lane, unsigned char* lds) {
    const int tid = wave * 64 + lane, qs = wave & 3, c = wave >> 2;
    const int r = lane & 31, hf = lane >> 5, krow = krow_of(r), tq0 = tqb + 32 * qs, t = tq0 + r;
    const float slope2 = exp2f(-2.0f * (float)(h + 1)) * LOG2E;
    const int kc_ = tid >> 8, kkey = (tid >> 3) & 31, kch = tid & 7;
    const bf16_t* kg = QK + (size_t)(b * S_ + kkey) * LDP0 + 1536 + (h * 2 + kc_) * 64 + kch * 8;
    const int klds = kc_ * DF_KB + kkey * 144 + kch * 16;
    const int vd = tid >> 2, vch = tid & 3;
    const bf16_t* vg = VT + ((size_t)(8 + 2 * h + (vd >> 6)) * 1024 + (size_t)(b * S_ >> 5)) * 2048 + vfrag_off(vd & 63, vch);
    const int vlds = DF_VOFF + vd * 80 + vch * 16;
    const int kfo = c * DF_KB + krow * 144 + hf * 16, vfo = DF_VOFF + r * 80 + hf * 16;
    bf16x8 qf[4];
#pragma unroll
    for (int ks = 0; ks < 4; ++ks) qf[ks] = ldg8(QK + (size_t)(b * S_ + t) * LDP0 + 1024 + (h * 2 + c) * 64 + 8 * hf + 16 * ks);
    f32x16 o[4];
#pragma unroll
    for (int dt = 0; dt < 4; ++dt) o[dt] = zero16();
    float m = 0.f, l = 0.f; bool seen = false;
    float ub; { float qq = 0.f;
#pragma unroll
        for (int ks = 0; ks < 4; ++ks)
#pragma unroll
            for (int e = 0; e < 8; ++e) { const float v = bf2f((bf16_t)qf[ks][e]); qq += v * v; }
        qq += __shfl_xor(qq, 32);
        const float k2 = __uint_as_float(__hip_atomic_load(kmx + b * 16 + (h * 2 + c) * 2, __ATOMIC_RELAXED, __HIP_MEMORY_SCOPE_AGENT)) + __uint_as_float(__hip_atomic_load(kmx + b * 16 + (h * 2 + c) * 2 + 1, __ATOMIC_RELAXED, __HIP_MEMORY_SCOPE_AGENT));
        ub = sqrtf(qq * k2 * 1.02f) * C1; }
    volatile unsigned* flags = (volatile unsigned*)(lds + DF_FLAGS);
    int kb = tqb + 64; int itn = 0;
    u32x4 kreg[2], vreg[2];
#pragma unroll
    for (int j = 0; j < 2; ++j) { kreg[j] = *(const u32x4*)(kg + (size_t)(kb + 32 * j) * LDP0); vreg[j] = *(const u32x4*)(vg + (size_t)((kb + 32 * j) >> 5) * 2048); }
#pragma unroll
    for (int j = 0; j < 2; ++j) { *(u32x4*)(lds + j * DF_BUF + klds) = kreg[j]; *(u32x4*)(lds + j * DF_BUF + vlds) = vreg[j]; }
    __syncthreads();
    int cur = 0;
#pragma unroll 1
    for (; kb >= 0; kb -= 64) {
        const bool more = kb > 0;
        if (more) {
#pragma unroll
            for (int j = 0; j < 2; ++j) { kreg[j] = *(const u32x4*)(kg + (size_t)(kb - 64 + 32 * j) * LDP0); vreg[j] = *(const u32x4*)(vg + (size_t)((kb - 64 + 32 * j) >> 5) * 2048); } }
        const unsigned char* B0 = lds + cur * DF_STEP; const unsigned char* B1 = B0 + DF_BUF;
        const bool a0 = kb <= tq0, a1 = kb + 32 <= tq0;
        if (a0) {
            f32x16 s1 = zero16(), s0 = zero16();
            if (a1) {
#pragma unroll
                for (int ks = 0; ks < 4; ++ks) s1 = MFMA32(*(const bf16x8*)(B1 + kfo + ks * 32), qf[ks], s1); }
#pragma unroll
            for (int ks = 0; ks < 4; ++ks) s0 = MFMA32(*(const bf16x8*)(B0 + kfo + ks * 32), qf[ks], s0);
            float alpha;
            if (a1) {
                const int tmk = t - kb - 32;
                if (soft_core(s1, -slope2 * (float)(tmk - 8 * hf), slope2, kb + 32 == tq0, tmk - 8 * hf, 1 << 30, m, seen, l, alpha)) {
#pragma unroll
                    for (int dt = 0; dt < 4; ++dt) o[dt] *= alpha; }
                const bf16x8 p0 = pack8(s1[0], s1[1], s1[2], s1[3], s1[4], s1[5], s1[6], s1[7]), p1 = pack8(s1[8], s1[9], s1[10], s1[11], s1[12], s1[13], s1[14], s1[15]);
#pragma unroll
                for (int dt = 0; dt < 4; ++dt) { o[dt] = MFMA32(*(const bf16x8*)(B1 + vfo + dt * (32 * 80)), p0, o[dt]); o[dt] = MFMA32(*(const bf16x8*)(B1 + vfo + dt * (32 * 80) + 32), p1, o[dt]); }
            }
            {
                const int tmk = t - kb;
                if (soft_core(s0, -slope2 * (float)(tmk - 8 * hf), slope2, kb == tq0, tmk - 8 * hf, 1 << 30, m, seen, l, alpha)) {
#pragma unroll
                    for (int dt = 0; dt < 4; ++dt) o[dt] *= alpha; }
                const bf16x8 p0 = pack8(s0[0], s0[1], s0[2], s0[3], s0[4], s0[5], s0[6], s0[7]), p1 = pack8(s0[8], s0[9], s0[10], s0[11], s0[12], s0[13], s0[14], s0[15]);
#pragma unroll
                for (int dt = 0; dt < 4; ++dt) { o[dt] = MFMA32(*(const bf16x8*)(B0 + vfo + dt * (32 * 80)), p0, o[dt]); o[dt] = MFMA32(*(const bf16x8*)(B0 + vfo + dt * (32 * 80) + 32), p1, o[dt]); }
            }
        }
        if (more) { unsigned char* N = lds + (cur ^ 1) * DF_STEP;
#pragma unroll
            for (int j = 0; j < 2; ++j) { *(u32x4*)(N + j * DF_BUF + klds) = kreg[j]; *(u32x4*)(N + j * DF_BUF + vlds) = vreg[j]; } }
        { const bool mine = seen && (ub - slope2 * (float)(t - kb + 1) - m < -150.f);
          const bool dn = a0 && __all(mine);
          if (lane == 0) flags[(itn & 1) * 8 + wave] = dn ? 1u : 0u; }
        __syncthreads();
        cur ^= 1;
        { const volatile unsigned* f = flags + (itn & 1) * 8; const unsigned a = f[0] & f[1] & f[2] & f[3] & f[4] & f[5] & f[6] & f[7]; ++itn; if (a) break; }
    }
    l += __shfl_xor(l, 32);
    float* X = (float*)(lds + DF_X) + qs * 4096 + lane;
    if (c == 1) { const float i1 = lam / l;
#pragma unroll
        for (int dt = 0; dt < 4; ++dt)
#pragma unroll
            for (int j = 0; j < 16; ++j) X[(dt * 16 + j) * 64] = o[dt][j] * i1; }
    __syncthreads();
    if (c == 0) {
        const float i0 = 1.f / l; float ss = 0.f;
#pragma unroll
        for (int dt = 0; dt < 4; ++dt)
#pragma unroll
            for (int j = 0; j < 16; ++j) { const float v = o[dt][j] * i0 - X[(dt * 16 + j) * 64]; o[dt][j] = v; ss += v * v; }
        ss += __shfl_xor(ss, 32);
        const float rs = rsqrtf(ss * (1.f / 128.f) + RMS_EPS) * 0.8f;
        bf16_t* orow = O + (size_t)(b * S_ + t) * DM + 512 + h * 128;
#pragma unroll
        for (int dt = 0; dt < 4; ++dt)
#pragma unroll
            for (int q = 0; q < 4; ++q) { const int d = 32 * dt + 8 * q + 4 * hf; const f32x4 gsub = *(const f32x4*)(subln + d);
                u32x2 w; w.x = pk2(o[dt][4 * q] * rs * gsub.x, o[dt][4 * q + 1] * rs * gsub.y); w.y = pk2(o[dt][4 * q + 2] * rs * gsub.z, o[dt][4 * q + 3] * rs * gsub.w);
                *(u32x2*)(orow + d) = w; }
    }
}
DI void phase_attn0(const Params& p, unsigned char* lds, int wave, int lane, int rep = 0) {
    const bf16_t* QK = (const bf16_t*)(p.ws + WS_BIG); const bf16_t* VT = (const bf16_t*)(p.ws + WS_VT); bf16_t* O = (bf16_t*)(p.ws + WS_XN);
    const float d1 = wave_sum(p.in[5][lane] * p.in[6][lane]), d2 = wave_sum(p.in[7][lane] * p.in[8][lane]);
    const float lam = expf(d1) - expf(d2) + 0.2f;
    {
        unsigned* qctr = (unsigned*)(p.ws + WS_QCTR) + rep;
        volatile unsigned* qidx = (volatile unsigned*)(lds + DF_QIDX);
        for (;;) {
            if (threadIdx.x == 0) qidx[0] = atomicAdd(qctr, 1u);
            __syncthreads();
            const unsigned idx = qidx[0];
            __syncthreads();
            if (idx >= 1024u) break;
            const int bh = idx & 15, qt = 63 - (int)(idx >> 4);
            diff_block(QK, VT, O, p.in[9], (const unsigned*)(p.ws + WS_KMX), lam, bh >> 2, bh & 3, qt * 128, wave, lane, lds);
        }
    }
#pragma nounroll
    for (int rep = 0; rep < (PROBE_DUP == 22 ? 2 : 1); ++rep)
    for (int idx = blockIdx.x; idx < 1024; idx += gridDim.x) {
        const int bh = idx >> 5, qt = idx & 31;
        sb_wave(QK, VT, O, bh >> 3, bh & 7, qt * 256 + wave * 32, lane);
    }
}

DI float gelu_tanh(float x) { const float u = 0.7978845608028654f * (x + 0.044715f * x * x * x); const float e = fexp2(2.f * LOG2E * u); return 0.5f * x * (2.f - 2.f / (e + 1.f)); }
DI void phase_compress(const Params& p, unsigned char* lds, int wave, int lane) {
    const bf16_t* P1 = (const bf16_t*)(p.ws + WS_BIG);
    bf16_t* H = (bf16_t*)lds;
    const int r = lane & 31, hf = lane >> 5;
    for (int u = blockIdx.x; u < 512; u += gridDim.x) {
        const int kv = u >> 8, b = (u >> 6) & 3, g = (u >> 4) & 3, it = u & 15, i0 = 32 * it;
        const bf16_t* W1 = (const bf16_t*)(p.ws + WS_WC1 + (size_t)kv * MiB); const bf16_t* W2 = (const bf16_t*)(p.ws + WS_WC2 + (size_t)kv * 32 * 1024);
        const float* bias = (const float*)(p.ws + WS_BIAS) + kv * 256;
        unsigned char* AL = lds + 17408;
        { const bf16_t* src = P1 + (size_t)(b * S_) * LDP1 + 1024 + kv * 256 + g * 64;
          u32x4 tmp[9];
#pragma unroll
          for (int j = 0; j < 9; ++j) { const int c = min((int)threadIdx.x + 512 * j, 528 * 8 - 1), tl = c >> 3, ch = c & 7; const int tok = min(16 * i0 + tl, S_ - 1);
              tmp[j] = *(const u32x4*)(src + (size_t)tok * LDP1 + ch * 8); }
#pragma unroll
          for (int j = 0; j < 9; ++j) { const int c = (int)threadIdx.x + 512 * j, tl = c >> 3, ch = c & 7;
              if (c < 528 * 8) *(u32x4*)(AL + tl * 128 + (tl >> 7) * 128 + ((ch ^ ((tl >> 4) & 7)) << 4)) = tmp[j]; } }
        __syncthreads();
        const bf16_t* bp = W1 + (size_t)wave * 512 + lane * 8;
        f32x16 acc = zero16();
        bf16x8 rb[4][8];
#pragma unroll
        for (int gq = 0; gq < 4; ++gq)
#pragma unroll
            for (int u8 = 0; u8 < 8; ++u8) rb[gq][u8] = ldg8(bp + (size_t)(gq * 8 + u8) * 4096);
#pragma unroll 1
        for (int k0 = 0; k0 < 128; k0 += 32) {
#pragma unroll
            for (int gq = 0; gq < 4; ++gq) {
#pragma unroll
                for (int u8 = 0; u8 < 8; ++u8) { const int kk = k0 + gq * 8 + u8; const int tl = 16 * r + (kk >> 2), ch = 2 * (kk & 3) + hf;
                    acc = MFMA32(*(const bf16x8*)(AL + tl * 128 + (tl >> 7) * 128 + ((ch ^ ((tl >> 4) & 7)) << 4)), rb[gq][u8], acc); }
                if (k0 + 32 < 128) {
#pragma unroll
                    for (int u8 = 0; u8 < 8; ++u8) rb[gq][u8] = ldg8(bp + (size_t)(k0 + 32 + gq * 8 + u8) * 4096); }
            }
        }
        const float bj = bias[32 * wave + r];
#pragma unroll
        for (int j = 0; j < 16; ++j) { const int row = (j & 3) + 8 * (j >> 2) + 4 * hf; const float hval = gelu_tanh(acc[j] + bj);
            H[row * 264 + 32 * wave + r] = (bf16_t)(pk2(hval, 0.f) & 0xffffu); }
        __syncthreads();
        if (wave < 2) {
            f32x16 a2 = zero16();
            const bf16_t* hp = H + r * 264 + 8 * hf; const bf16_t* wp = W2 + (size_t)(32 * wave + r) * 256 + 8 * hf;
#pragma unroll
            for (int k2 = 0; k2 < 16; ++k2) a2 = MFMA32(*(const bf16x8*)(hp + 16 * k2), ldg8(wp + 16 * k2), a2);
            const int d = 32 * wave + r;
            if (kv == 0) {
                float mx = 0.f;
#pragma unroll
                for (int j = 0; j < 16; ++j) { float q = a2[j] * a2[j]; q += __shfl_xor(q, 1); q += __shfl_xor(q, 2); q += __shfl_xor(q, 4); q += __shfl_xor(q, 8); q += __shfl_xor(q, 16); mx = fmaxf(mx, q); }
                mx = fmaxf(mx, __shfl_xor(mx, 32));
                if (lane == 0) atomicMax((unsigned*)(p.ws + WS_KMX) + 96 + (b * 4 + g) * 2 + wave, __float_as_uint(mx)); }
            if (kv == 0) { bf16_t* kc = (bf16_t*)(p.ws + WS_KC) + (size_t)((b * 4 + g) * 512) * 64;
#pragma unroll
                for (int j = 0; j < 16; ++j) { const int i = i0 + (j & 3) + 8 * (j >> 2) + 4 * hf; kc[(size_t)i * 64 + d] = i < 511 ? (bf16_t)(pk2(a2[j], 0.f) & 0xffffu) : (bf16_t)0; }
            } else { bf16_t* vct = (bf16_t*)(p.ws + WS_VCT) + ((size_t)((b * 4 + g) * 16 + it) * 64 + d) * 32 - i0;
#pragma unroll
                for (int q = 0; q < 8; ++q) { const int j = (q >> 1) * 4 + (q & 1) * 2; const int i = i0 + (j & 3) + 8 * (j >> 2) + 4 * hf;
                    const float lo = a2[j], hi = (i + 1 < 511) ? a2[j + 1] : 0.f; *(unsigned*)(vct + i) = pk2(lo, hi); }
            }
        }
        __syncthreads();
    }
}

constexpr int NS_VOFF = 4608, NS_BUF = 9728, NS_BASE = 8 * WAVE_LDS;
DI f32x16 qk_lds(const unsigned char* B, const bf16x8 (&qf)[4], int krow, int hf) {
    f32x16 s = zero16();
#pragma unroll
    for (int ks = 0; ks < 4; ++ks) s = MFMA32(*(const bf16x8*)(B + krow * 144 + hf * 16 + ks * 32), qf[ks], s);
    return s; }
DI void pv_lds(const unsigned char* B, const bf16x8& p0, const bf16x8& p1, f32x16& o0, f32x16& o1, int r, int hf) {
    const unsigned char* v = B + NS_VOFF + r * 80 + hf * 16;
    o0 = MFMA32(*(const bf16x8*)(v), p0, o0); o1 = MFMA32(*(const bf16x8*)(v + 32 * 80), p0, o1);
    o0 = MFMA32(*(const bf16x8*)(v + 32), p1, o0); o1 = MFMA32(*(const bf16x8*)(v + 32 * 80 + 32), p1, o1); }
DI void nsa_block(const bf16_t* P1, const bf16_t* VT1, const bf16_t* KSF, const bf16_t* KC, const bf16_t* VCT, bf16_t* O, const unsigned* kmx, int b, int g, int t0b, int wave, int lane, unsigned char* lds) {
    unsigned char* wl = lds + wave * WAVE_LDS; unsigned char* SB = lds + NS_BASE;
    const int t0w = t0b + 8 * wave, tid = wave * 64 + lane;
    const bool kst = wave < 4;
    const int st_row = kst ? (tid >> 3) : ((tid - 256) >> 2), st_ch = kst ? (tid & 7) : ((tid - 256) & 3);
    const int st_dst = kst ? st_row * 144 + st_ch * 16 : NS_VOFF + st_row * 80 + st_ch * 16;
    u32x4 sreg = {0u, 0u, 0u, 0u};
    float* impA = (float*)wl; float* impB = impA + 1024; unsigned long long* selm = (unsigned long long*)(wl + 8192);
    const int r = lane & 31, hf = lane >> 5, tk = r >> 2, hh = r & 3, krow = krow_of(r);
    const int t = t0w + tk, head = g * 4 + hh, tmax = t0w + 7;
    const float slope2 = exp2f(-0.5f * (float)(head + 1)) * LOG2E;
    const bf16_t* prow = P1 + (size_t)(b * S_ + t) * LDP1;
    bf16x8 qf[4];
#pragma unroll
    for (int ks = 0; ks < 4; ++ks) qf[ks] = ldg8(prow + head * 64 + 8 * hf + 16 * ks);
    const float gc = 1.f / (1.f + __expf(-bf2f(prow[2048 + head * 3 + 0]))), gs = 1.f / (1.f + __expf(-bf2f(prow[2048 + head * 3 + 1]))), gwn = 1.f / (1.f + __expf(-bf2f(prow[2048 + head * 3 + 2])));
#pragma unroll
    for (int i = 0; i < 16; ++i) { impA[lane + 64 * i] = 0.f; impB[lane + 64 * i] = 0.f; }
    wave_lds_sync();
    const int nmax = tmax >= 31 ? ((tmax - 31) >> 4) + 1 : 0, ntile = (nmax + 31) >> 5;
    const bf16_t* kcb = KC + (size_t)((b * 4 + g) * 512) * 64;
    const bf16_t* vcb = VCT + (size_t)((b * 4 + g) * 64) * 512;
    int lo_b = 0, lo_w = 0;
    { float qq = 0.f;
#pragma unroll
      for (int ks = 0; ks < 4; ++ks)
#pragma unroll
          for (int e = 0; e < 8; ++e) { const float v = bf2f((bf16_t)qf[ks][e]); qq += v * v; }
      qq += __shfl_xor(qq, 32);
      const unsigned* kcm = kmx + 96 + (b * 4 + g) * 2;
      const float kc2 = __uint_as_float(__hip_atomic_load(kcm, __ATOMIC_RELAXED, __HIP_MEMORY_SCOPE_AGENT)) + __uint_as_float(__hip_atomic_load(kcm + 1, __ATOMIC_RELAXED, __HIP_MEMORY_SCOPE_AGENT));
      const float ubc = sqrtf(qq * kc2 * 1.02f) * C1;
      const float Dcol = (150.f + 2.f * ubc) / slope2 + 15.f;
      const float f = (((float)(t - 31) - Dcol) * (1.f / 16.f) - 31.f) * (1.f / 32.f);
      int lo = f > 0.f ? (int)floorf(f) : 0;
#pragma unroll
      for (int o = 1; o < 64; o <<= 1) lo = min(lo, __shfl_xor(lo, o));
      lo_w = lo;
      volatile int* xl = (volatile int*)(SB + 2 * NS_BUF + 64);
      if (lane == 0) xl[wave] = lo_w;
      __syncthreads();
      lo_b = min(min(min(xl[0], xl[1]), min(xl[2], xl[3])), min(min(xl[4], xl[5]), min(xl[6], xl[7]))); }
    float m = -1e30f, l = 0.f;
    const int tmaxb = t0b + 63, ntb = ((tmaxb >= 31 ? ((tmaxb - 31) >> 4) + 1 : 0) + 31) >> 5;
#define NS_CMP_SRC(n) (kst ? kcb + (size_t)(32 * (n) + st_row) * 64 + st_ch * 8 : vcb + (size_t)(n) * 2048 + st_row * 32 + st_ch * 8)
    if (ntb > lo_b) {
        if (kst) sreg = *(const u32x4*)NS_CMP_SRC(lo_b);
        if (kst) *(u32x4*)(SB + st_dst) = sreg;
        __syncthreads();
#pragma unroll 1
        for (int it = lo_b; it < ntb; ++it) {
            if (kst && it + 1 < ntb) sreg = *(const u32x4*)NS_CMP_SRC(it + 1);
            const unsigned char* B = SB + ((it - lo_b) & 1) * NS_BUF;
            if (it >= lo_w && it < ntile) {
                const int ib = 32 * it;
                f32x16 s = qk_lds(B, qf, krow, hf);
#pragma unroll
                for (int j = 0; j < 16; ++j) { const int dist = t - 31 - 16 * (ib + 16 * (j >> 3) + 8 * hf + (j & 7)); s[j] = dist >= 0 ? s[j] * C1 - slope2 * (float)dist : -INFINITY; }
                float alpha; softmax_tile(s, m, l, alpha);
            }
            if (kst && it + 1 < ntb) *(u32x4*)(SB + ((it + 1 - lo_b) & 1) * NS_BUF + st_dst) = sreg;
            __syncthreads();
        }
    }
    l += __shfl_xor(l, 32);
    const float inv = (t >= 31) ? 1.f / l : 0.f;
    f32x16 of0 = zero16(), of1 = zero16();
    if (ntb > lo_b) {
        sreg = *(const u32x4*)NS_CMP_SRC(lo_b);
        *(u32x4*)(SB + st_dst) = sreg;
        __syncthreads();
    }
#pragma unroll 1
    for (int it = lo_b; it < ntb; ++it) {
        if (it + 1 < ntb) sreg = *(const u32x4*)NS_CMP_SRC(it + 1);
        const unsigned char* B = SB + ((it - lo_b) & 1) * NS_BUF;
        if (it >= lo_w && it < ntile) {
        const int ib = 32 * it;
        f32x16 s = qk_lds(B, qf, krow, hf);
#pragma unroll
        for (int j = 0; j < 16; ++j) { const int dist = t - 31 - 16 * (ib + 16 * (j >> 3) + 8 * hf + (j & 7)); s[j] = dist >= 0 ? fexp2(s[j] * C1 - slope2 * (float)dist - m) * inv : 0.f; }
#pragma unroll
        for (int q = 0; q < 4; ++q) {
            float gsum = (s[4 * q] + s[4 * q + 1]) + (s[4 * q + 2] + s[4 * q + 3]), e = s[4 * q + 3];
            gsum += __shfl_xor(gsum, 1); gsum += __shfl_xor(gsum, 2); e += __shfl_xor(e, 1); e += __shfl_xor(e, 2);
            const int ssel = (ib >> 2) + 4 * (q >> 1) + 2 * hf + (q & 1);
            if (hh == 0) { impA[tk * 128 + ssel] = gsum; if (ssel + 1 < 128) impB[tk * 128 + ssel + 1] = e; }
        }
        const bf16x8 p0 = pack8(s[0], s[1], s[2], s[3], s[4], s[5], s[6], s[7]), p1 = pack8(s[8], s[9], s[10], s[11], s[12], s[13], s[14], s[15]);
        pv_lds(B, p0, p1, of0, of1, r, hf);
        }
        if (it + 1 < ntb) *(u32x4*)(SB + ((it + 1 - lo_b) & 1) * NS_BUF + st_dst) = sreg;
        __syncthreads();
    }
#undef NS_CMP_SRC
    of0 *= gc; of1 *= gc;
    wave_lds_sync();
    const unsigned long long lt_mask = (1ull << lane) - 1ull;
    for (int k2 = 0; k2 < 8; ++k2) {
        const int cur = (t0w + k2) >> 6;
        unsigned long long ma, mb;
        if (cur < 16) { ma = __ballot(lane <= cur); mb = 0ull; }
        else {
            const float va = impA[k2 * 128 + lane] + impB[k2 * 128 + lane], vb = impA[k2 * 128 + 64 + lane] + impB[k2 * 128 + 64 + lane];
            const int sa = lane, sb = lane + 64;
            const unsigned ka = (sa >= 1 && sa <= cur - 2) ? __float_as_uint(va) + 1u : 0u, kb = (sb <= cur - 2) ? __float_as_uint(vb) + 1u : 0u;
            unsigned tau = 0u;
            for (int bit = 31; bit >= 0; --bit) { const unsigned trial = tau | (1u << bit);
                const int cnt = __popcll(__ballot(ka >= trial)) + __popcll(__ballot(kb >= trial)); if (cnt >= 13) tau = trial; }
            const unsigned long long eqA = __ballot(ka == tau), eqB = __ballot(kb == tau);
            const int need = 13 - __popcll(__ballot(ka > tau)) - __popcll(__ballot(kb > tau));
            const int rankA = __popcll(eqA & lt_mask), rankB = __popcll(eqA) + __popcll(eqB & lt_mask);
            const bool selA = (ka > tau) || (ka == tau && rankA < need) || sa == 0 || sa == cur || sa == cur - 1;
            const bool selB = (kb > tau) || (kb == tau && rankB < need) || sb == cur || sb == cur - 1;
            ma = __ballot(selA); mb = __ballot(selB);
        }
        if (lane == 0) { selm[2 * k2] = ma; selm[2 * k2 + 1] = mb; }
    }
    wave_lds_sync();
    const unsigned long long mlo = selm[2 * tk], mhi = selm[2 * tk + 1];
    unsigned long long ulo = 0ull, uhi = 0ull;
#pragma unroll
    for (int k2 = 0; k2 < 8; ++k2) { ulo |= selm[2 * k2]; uhi |= selm[2 * k2 + 1]; }
    const bf16_t* ksb = KSF + ((size_t)g * 1024 + (size_t)(b * S_ >> 5)) * 2048; const bf16_t* vsb = VT1 + ((size_t)g * 1024 + (size_t)(b * S_ >> 5)) * 2048;
    const bf16_t* kwb = P1 + (size_t)(b * S_) * LDP1 + 1792 + g * 64; const bf16_t* vwb = VT1 + ((size_t)(4 + g) * 1024 + (size_t)(b * S_ >> 5)) * 2048;
    {
        f32x16 o0 = zero16(), o1 = zero16(); m = 0.f; l = 0.f; bool seen = false;
        float ubq; { float qq = 0.f;
#pragma unroll
            for (int ks = 0; ks < 4; ++ks)
#pragma unroll
                for (int e = 0; e < 8; ++e) { const float v = bf2f((bf16_t)qf[ks][e]); qq += v * v; }
            qq += __shfl_xor(qq, 32);
            const float k2 = __uint_as_float(__hip_atomic_load(kmx + 64 + b * 8 + 2 * g, __ATOMIC_RELAXED, __HIP_MEMORY_SCOPE_AGENT)) + __uint_as_float(__hip_atomic_load(kmx + 64 + b * 8 + 2 * g + 1, __ATOMIC_RELAXED, __HIP_MEMORY_SCOPE_AGENT));
            ubq = sqrtf(qq * k2 * 1.02f) * C1; }
        bool stop = false;
#pragma unroll 1
        for (int half = 1; half >= 0 && !stop; --half) {
            unsigned long long U = half ? uhi : ulo; const unsigned long long mine = half ? mhi : mlo;
            U = ((unsigned long long)__builtin_amdgcn_readfirstlane((unsigned)(U >> 32)) << 32) | (unsigned long long)__builtin_amdgcn_readfirstlane((unsigned)U);
            while (U) {
                const int bit = 63 - __builtin_clzll(U); U &= ~(1ull << bit);
                const bool colok = (mine >> bit) & 1ull;
                const int kb0 = (bit + 64 * half) * 64;
                if (__all(seen && (ubq - slope2 * (float)(t - (kb0 + 63)) - m < -150.f))) { stop = true; break; }
#pragma unroll 1
                for (int sub = 0; sub < 2; ++sub) { const int kb = kb0 + 32 * sub; if (kb > tmax) break;
                    soft_tile64(ksb + (size_t)(kb >> 5) * 2048, vsb + (size_t)(kb >> 5) * 2048, qf, t - kb, 1 << 30, colok, kb + 31 > t0w, slope2, lane, hf, m, seen, l, o0, o1); }
            }
        }
        l += __shfl_xor(l, 32);
        const float sc = gs / l; of0 += o0 * sc; of1 += o1 * sc;
    }
    {
        f32x16 o0 = zero16(), o1 = zero16(); m = 0.f; l = 0.f; bool seen = false;
        int lo = t0w - 511; if (lo < 0) lo = 0;
        const int kb_lo = lo & ~31, kb_hi = t0w & ~31;
        int lob = t0b - 511; if (lob < 0) lob = 0;
        const int kb_lob = lob & ~31, kb_hib = t0b + 32, nwt = ((kb_hib - kb_lob) >> 5) + 1;
#define NS_WIN_SRC(kb_) (kst ? kwb + (size_t)((kb_) + st_row) * LDP1 + st_ch * 8 : vwb + (size_t)((kb_) >> 5) * 2048 + vfrag_off(st_row, st_ch))
        sreg = *(const u32x4*)NS_WIN_SRC(kb_hib);
        *(u32x4*)(SB + st_dst) = sreg;
        __syncthreads();
#pragma unroll 1
        for (int n = 0; n < nwt; ++n) {
            const int kb = kb_hib - 32 * n;
            if (n + 1 < nwt) sreg = *(const u32x4*)NS_WIN_SRC(kb - 32);
            const unsigned char* B = SB + (n & 1) * NS_BUF;
            if (kb >= kb_lo && kb <= kb_hi) {
                f32x16 sc_ = qk_lds(B, qf, krow, hf);
                float alpha;
                if (soft_core(sc_, -slope2 * (float)(t - kb - 8 * hf), slope2, (kb + 31 > t0w) || (tmax - kb >= 512), t - kb - 8 * hf, 512, m, seen, l, alpha)) { o0 *= alpha; o1 *= alpha; }
                const bf16x8 p0 = pack8(sc_[0], sc_[1], sc_[2], sc_[3], sc_[4], sc_[5], sc_[6], sc_[7]), p1 = pack8(sc_[8], sc_[9], sc_[10], sc_[11], sc_[12], sc_[13], sc_[14], sc_[15]);
                pv_lds(B, p0, p1, o0, o1, r, hf);
            }
            if (n + 1 < nwt) *(u32x4*)(SB + ((n + 1) & 1) * NS_BUF + st_dst) = sreg;
            __syncthreads();
        }
#undef NS_WIN_SRC
        l += __shfl_xor(l, 32);
        const float sc = gwn / l; of0 += o0 * sc; of1 += o1 * sc;
    }
    store_o64(O + (size_t)(b * S_ + t) * DM + head * 64, of0, of1, hf);
}
DI void phase_nsa(const Params& p, unsigned char* lds, int wave, int lane, int rep = 0) {
    const bf16_t* P1 = (const bf16_t*)(p.ws + WS_BIG); const bf16_t* VT1 = (const bf16_t*)(p.ws + WS_VT);
    const bf16_t* KC = (const bf16_t*)(p.ws + WS_KC); const bf16_t* VCT = (const bf16_t*)(p.ws + WS_VCT); bf16_t* O = (bf16_t*)(p.ws + WS_XN);
    unsigned* qctr = (unsigned*)(p.ws + WS_QCTR) + 8 + rep;
    volatile unsigned* qidx = (volatile unsigned*)(lds + NS_BASE + 2 * NS_BUF);
    for (;;) {
        if (threadIdx.x == 0) qidx[0] = atomicAdd(qctr, 1u);
        __syncthreads();
        const unsigned idx = qidx[0];
        __syncthreads();
        if (idx >= 2048u) break;
        const int bg = idx & 15, tile = 127 - (int)(idx >> 4);
        nsa_block(P1, VT1, (const bf16_t*)(p.ws + WS_KSF), KC, VCT, O, (const unsigned*)(p.ws + WS_KMX), bg >> 2, bg & 3, tile * 64, wave, lane, lds);
    }
}

#define XB_TMO      128
#define XB_XCNT(j)  (256  + 64 * (j))
#define XB_XSUB(j)  (1280 + 64 * (j))
#define XB_XGEN(j)  (2304 + 64 * (j))
#define XB_TOP      3328
#define XB_TOPGEN   3392
#define XCD_BAR_WORDS 3456
#define XB_SPIN_CAP (1u << 18)
#define LAS __attribute__((address_space(3)))

__device__ __forceinline__ unsigned xb_ld(unsigned* p)              { return __hip_atomic_load(p, __ATOMIC_RELAXED, __HIP_MEMORY_SCOPE_AGENT); }
__device__ __forceinline__ unsigned xb_add(unsigned* p, unsigned v) { return __hip_atomic_fetch_add(p, v, __ATOMIC_RELAXED, __HIP_MEMORY_SCOPE_AGENT); }
__device__ __forceinline__ unsigned xb_xcc_id() { return (unsigned)__builtin_amdgcn_s_getreg((3 << 11) | 20) & 0xFu; }
#define XB_SPIN(cond, bar) do { unsigned _sp = 0; while (cond) { __builtin_amdgcn_s_sleep(1); \
    if ((++_sp & 255u) == 0u) { if (xb_ld(&(bar)[XB_TMO])) break; if (_sp > XB_SPIN_CAP) { atomicAdd(&(bar)[XB_TMO], 1u); break; } } } } while (0)

struct XcdBarrier {
    unsigned* bar; unsigned x;
    volatile LAS unsigned* st;
};

__device__ __forceinline__ XcdBarrier xcd_barrier_post(unsigned* bar, volatile LAS unsigned* st) {
    XcdBarrier b; b.bar = bar; b.x = xb_xcc_id(); b.st = st;
    if (threadIdx.x == 0) (void)xb_add(&bar[XB_XCNT(b.x)], 1u);
    return b;
}
__device__ __forceinline__ void xcd_barrier_complete(unsigned* bar, unsigned x, unsigned& nloc, unsigned& nx) {
    const unsigned G = gridDim.x * gridDim.y * gridDim.z;
    unsigned sum, cnt, mine, sp = 0u;
    for (;;) {
        sum = 0u; cnt = 0u; mine = 0u;
#pragma unroll
        for (unsigned j = 0; j < 16; ++j) { const unsigned c = xb_ld(&bar[XB_XCNT(j)]); sum += c; cnt += (c > 0u) ? 1u : 0u; mine = (j == x) ? c : mine; }
        if (sum == G) break;
        __builtin_amdgcn_s_sleep(1);
        if ((++sp & 255u) == 0u) { if (xb_ld(&bar[XB_TMO])) break; if (sp > XB_SPIN_CAP) { atomicAdd(&bar[XB_TMO], 1u); break; } }
    }
    nloc = mine > 0u ? mine : 1u; nx = cnt > 0u ? cnt : 1u;
}

__device__ __forceinline__ void xcd_barrier(const XcdBarrier& b) {
    asm volatile("s_waitcnt vmcnt(0)" ::: "memory");
    __syncthreads();
    if (threadIdx.x == 0) {
        unsigned* bar = b.bar;
        __builtin_amdgcn_s_waitcnt(0);
        unsigned nloc = b.st[0], nx = b.st[1];
        if (nloc == 0u) { xcd_barrier_complete(bar, b.x, nloc, nx); b.st[0] = nloc; b.st[1] = nx; }
        const unsigned old = xb_add(&bar[XB_XSUB(b.x)], 1u);
        const unsigned gen = old / nloc;
        if (old + 1u == (gen + 1u) * nloc) {
            __builtin_amdgcn_fence(__ATOMIC_RELEASE, "agent");
            asm volatile("s_waitcnt vmcnt(0)" ::: "memory");
            const unsigned og = xb_add(&bar[XB_TOP], 1u);
            const unsigned tg = og / nx;
            if (og + 1u == (tg + 1u) * nx) xb_add(&bar[XB_TOPGEN], 1u);
            else XB_SPIN(xb_ld(&bar[XB_TOPGEN]) == tg, bar);
            __builtin_amdgcn_fence(__ATOMIC_ACQUIRE, "agent");
            xb_add(&bar[XB_XGEN(b.x)], 1u);
            asm volatile("s_waitcnt vmcnt(0)" ::: "memory");
        } else {
            XB_SPIN(xb_ld(&bar[XB_XGEN(b.x)]) == gen, bar);
            __builtin_amdgcn_fence(__ATOMIC_ACQUIRE, "agent");
            asm volatile("s_waitcnt vmcnt(0)" ::: "memory");
        }
    }
    __syncthreads();
}

static_assert(XCD_BAR_WORDS * 4 == 13824, "queue counter sits right behind the barrier words");
DI void rs_for_units(int M, int N, bool by_col, const float* SS, float* RS) {
    pg8::StaticOrder S; S.init(M, N, (int)gridDim.x, (int)blockIdx.x);
    pg8::Unit u; int last = -1; const int tid = threadIdx.x;
    for (int i = 0; S.next(i, u); ++i) {
        const int panel = by_col ? u.pn : u.pm;
        if (panel == last) continue;
        last = panel;
        const int row = panel * 256 + (tid >> 1);
        const f32x4* pp = (const f32x4*)(SS + (size_t)row * 16 + (tid & 1) * 8);
        const f32x4 a = pp[0], b = pp[1];
        float v = ((a[0] + a[1]) + (a[2] + a[3])) + ((b[0] + b[1]) + (b[2] + b[3]));
        v += __shfl_xor(v, 1);
        if ((tid & 1) == 0) RS[row] = rsqrtf(v * (1.f / DM) + RMS_EPS);
    }
    asm volatile("s_waitcnt vmcnt(0)" ::: "memory");
    __syncthreads();
}
template <class Epi> DI void run_gemm(unsigned char* lds, const bf16_t* A, const bf16_t* Bt, int M, int N, int K, const Epi& E) {
    pg8::Gemm g{A, Bt, M, N, K}; pg8::StaticOrder S; S.init(M, N, (int)gridDim.x, (int)blockIdx.x);
    pg8::gemm_phase<Epi, pg8::StaticOrder, true, true>((PG8_LAS unsigned char*)lds, g, S, E);
}
#ifndef PROBE_DUP
#define PROBE_DUP 0
#endif
#ifndef ONLY_PHASE
#define ONLY_PHASE -1
#endif
#define PH_EN(n) (ONLY_PHASE < 0 || ONLY_PHASE == (n))
constexpr int NPHASE = 16;
__global__ void __launch_bounds__(512) trunk_fwd(Params p) {
    extern __shared__ __attribute__((aligned(16))) unsigned char lds[];
    cg::grid_group grid = cg::this_grid();
    const int tid = threadIdx.x, lane = tid & 63, wave = __builtin_amdgcn_readfirstlane(tid >> 6);
    const int gw = blockIdx.x * 8 + wave, ngw = gridDim.x * 8;
    unsigned char* ws = p.ws;
    bf16_t* XN = (bf16_t*)(ws + WS_XN); bf16_t* BIG = (bf16_t*)(ws + WS_BIG); bf16_t* VT = (bf16_t*)(ws + WS_VT);
    const int lo = p.ph_lo, hi = p.ph_hi;
    if (hi > 1000) grid.sync();
    if (tid < 4) ((unsigned*)(lds + LDS_GEMM))[tid] = 0u;
    __syncthreads();
    XcdBarrier xbar = xcd_barrier_post((unsigned*)(ws + WS_BAR), (volatile LAS unsigned*)(lds + LDS_GEMM));
#define IN(k) (PH_EN(k) && lo <= (k) && (k) < hi)
#define SEAM(k) do { if ((k) + 1 < hi) { _Pragma("nounroll") for (int rep_ = 0; rep_ < (PROBE_DUP == 99 ? 3 : 1); ++rep_) xcd_barrier(xbar); } } while (0)
    if (IN(0)) {
#pragma nounroll
        for (int rep = 0; rep < (PROBE_DUP == 100 ? 2 : 1); ++rep) phase_prologue(p, lds, wave, lane);
        SEAM(0); }
    bf16_t* XB = (bf16_t*)(ws + WS_XB); float* SS = (float*)(ws + WS_SS); float* RS = (float*)(ws + WS_RS);
#define RSTD_PASS() do { for (int r4 = gw * 4; r4 < T_; r4 += ngw * 4) { float v = SS[(size_t)r4 * 16 + lane]; v += __shfl_xor(v, 1); v += __shfl_xor(v, 2); v += __shfl_xor(v, 4); v += __shfl_xor(v, 8); if ((lane & 15) == 0) RS[r4 + (lane >> 4)] = rsqrtf(v * (1.f / DM) + RMS_EPS); } } while (0)
    if (IN(1)) { run_gemm(lds, XB, (const bf16_t*)(ws + WS_W0QK), T_, 2048, DM, pg8::EpiB<0, true, 1>{BIG, LDP0, (unsigned*)(ws + WS_KMX), 6, 8, RS, nullptr, -1});
                 run_gemm(lds, (const bf16_t*)(ws + WS_W0V), XB, 1024, T_, DM, pg8::EpiB<0, false, 2, true>{VT, T_, nullptr, 0, 0, RS, nullptr, -1}); SEAM(1); }
    if (IN(2)) {
#pragma nounroll
        for (int rep = 0; rep < (PROBE_DUP == 2 ? 2 : 1); ++rep) phase_attn0(p, lds, wave, lane, rep);
        SEAM(2); }
    if (IN(3)) { run_gemm(lds, XN, (const bf16_t*)(ws + WS_W0O), T_, DM, DM, pg8::EpiRb<true>{XB, DM, SS}); SEAM(3); }
    if (IN(5)) { rs_for_units(T_, FF, false, SS, RS);
                 run_gemm(lds, XB, (const bf16_t*)(ws + WS_WM1), T_, FF, DM, pg8::EpiB<1, false, 1>{BIG, FF, nullptr, 0, 0, RS, nullptr, -1}); SEAM(5); }
    if (IN(6)) { run_gemm(lds, BIG, (const bf16_t*)(ws + WS_WM2), T_, DM, FF, pg8::EpiRb<true>{XB, DM, SS}); SEAM(6); }
    if (IN(8)) { rs_for_units(T_, LDP1, false, SS, RS); rs_for_units(512, T_, true, SS, RS);
                 run_gemm(lds, XB, (const bf16_t*)(ws + WS_W1A), T_, LDP1, DM, pg8::EpiB<0, true, 1>{BIG, LDP1, (unsigned*)(ws + WS_KMX) + 64, 6, 7, RS, (bf16_t*)(ws + WS_KSF), 6});
                 run_gemm(lds, (const bf16_t*)(ws + WS_W1V), XB, 512, T_, DM, pg8::EpiB<0, false, 2, true>{VT, T_, nullptr, 0, 0, RS, nullptr, -1}); SEAM(8); }
    if (IN(9)) {
#pragma nounroll
        for (int rep = 0; rep < (PROBE_DUP == 9 ? 2 : 1); ++rep) phase_compress(p, lds, wave, lane);
        SEAM(9); }
    if (IN(10)) {
#pragma nounroll
        for (int rep = 0; rep < (PROBE_DUP == 10 ? 2 : 1); ++rep) phase_nsa(p, lds, wave, lane, rep);
        SEAM(10); }
    if (IN(11)) { run_gemm(lds, XN, (const bf16_t*)(ws + WS_W1O), T_, DM, DM, pg8::EpiRb<true>{XB, DM, SS}); SEAM(11); }
    if (IN(13)) { rs_for_units(T_, FF, false, SS, RS);
                  run_gemm(lds, XB, (const bf16_t*)(ws + WS_WM1 + 8 * MiB), T_, FF, DM, pg8::EpiB<1, false, 1>{BIG, FF, nullptr, 0, 0, RS, nullptr, -1}); SEAM(13); }
    if (IN(14)) { run_gemm(lds, BIG, (const bf16_t*)(ws + WS_WM2 + 8 * MiB), T_, DM, FF, pg8::EpiRb<false>{XB, DM, nullptr}); SEAM(14); }
    if (IN(15)) { final_rows(XB, p.in[3], p.out, gw, ngw, lane); }
#undef IN
#undef RSTD_PASS
#undef SEAM
}

#ifndef MK_PER_PHASE
#define MK_PER_PHASE 0
#endif
extern "C" void kernel_launch(void* const* d_in, const int* in_sizes, int n_in, void* d_out, int out_size, void* d_ws, size_t ws_size, hipStream_t stream) {
    static int grid = 0;
    if (grid == 0) {
        int dev = 0, cus = 0, per_cu = 0;
        (void)hipGetDevice(&dev);
        (void)hipDeviceGetAttribute(&cus, hipDeviceAttributeMultiprocessorCount, dev);
        if (hipFuncSetAttribute((const void*)trunk_fwd, hipFuncAttributeMaxDynamicSharedMemorySize, LDS_BYTES) != hipSuccess) fprintf(stderr, "kernel_launch: hipFuncSetAttribute failed\n");
        if (hipOccupancyMaxActiveBlocksPerMultiprocessor(&per_cu, (const void*)trunk_fwd, 512, LDS_BYTES) != hipSuccess || per_cu < 1) { fprintf(stderr, "kernel_launch: occupancy query says %d\n", per_cu); per_cu = 1; }
        (void)hipGetLastError();
        grid = cus * 1;
        if (n_in != 21 || ws_size < WS_END) fprintf(stderr, "kernel_launch: unexpected n_in %d / ws %zu\n", n_in, ws_size);
    }
    (void)hipMemsetAsync((unsigned char*)d_ws + WS_BAR, 0, (XCD_BAR_WORDS + 64) * sizeof(unsigned), stream);
    Params p{};
    for (int i = 0; i < 21; ++i) p.in[i] = (const float*)d_in[i];
    p.out = (float*)d_out; p.ws = (unsigned char*)d_ws;
#if MK_PER_PHASE
    for (int ph = 0; ph < NPHASE; ++ph) { p.ph_lo = ph; p.ph_hi = ph + 1; hipLaunchKernelGGL(trunk_fwd, dim3(grid), dim3(512), LDS_BYTES, stream, p); }
#else
    p.ph_lo = 0; p.ph_hi = NPHASE;
    void* args[] = {&p};
    hipError_t e = hipLaunchCooperativeKernel((const void*)trunk_fwd, dim3(grid), dim3(512), args, LDS_BYTES, stream);
    if (e != hipSuccess) fprintf(stderr, "kernel_launch: cooperative launch failed: %s (grid %d)\n", hipGetErrorString(e), grid);
#endif
}
```

```cpp
#define PROBE_DUP 0
#include <hip/hip_runtime.h>
#include <hip/hip_cooperative_groups.h>
#include <cstdio>
#include <cstdint>
namespace cg = cooperative_groups;
namespace pg8 {
#define PG8_LAS __attribute__((address_space(3)))
typedef unsigned short bf16_t;
typedef short bf16x8 __attribute__((ext_vector_type(8)));
typedef float f32x4 __attribute__((ext_vector_type(4)));
typedef unsigned u32x4 __attribute__((ext_vector_type(4)));
constexpr int BM = 256, BK = 64, HALF = 128, HTB = HALF * BK * 2  , STAGE_BYTES = 8 * HTB, NXCD = 8, WGM = 4;

__host__ __device__ __forceinline__ int lds_byte(int r, int c) { const int st = (r >> 4) * 2 + (c >> 5), rr = r & 15, cc = c & 31, ob = rr * 64 + cc * 2; return st * 1024 + (ob ^ (((ob >> 9) & 1) << 5)); }
__host__ __device__ __forceinline__ void stage_rc(int b, int& R, int& C) { const int st = b / 1024, sb = b % 1024, swz = sb ^ (((sb >> 9) & 1) << 5); R = (st >> 1) * 16 + swz / 64; C = (st & 1) * 32 + (swz % 64) / 2; }
__host__ __device__ __forceinline__ int perm32(int rho) { const int n = rho >> 4, i = rho & 15; return 8 * (i >> 2) + 4 * n + (i & 3); }

struct Unit { int pm, pn; };
struct Gemm { const bf16_t* A; const bf16_t* Bt; int M, N, K; };

struct StaticOrder {
    int nM, nN, nwg, G, c;
    __host__ __device__ void init(int M, int N, int G_, int c_) { nM = M / BM; nN = N / BM; nwg = nM * nN; G = G_; c = c_; }
    __host__ __device__ bool next(int i, Unit& u) const {
        const long L = (long)i * G + c; if (L >= nwg) return false;
        int wgid = (int)L; { const int q = nwg / NXCD, r = nwg % NXCD, xcd = wgid % NXCD, off = wgid / NXCD; wgid = (xcd < r ? xcd * (q + 1) : r * (q + 1) + (xcd - r) * q) + off; }
        const int nig = WGM * nN, gid = wgid / nig, fm = gid * WGM, gsz = (nM - fm) < WGM ? (nM - fm) : WGM;
        u.pm = fm + ((wgid % nig) % gsz); u.pn = (wgid % nig) / gsz; return true;
    }
    __device__ __forceinline__ void a_ready(const Unit&) const {}
    __device__ __forceinline__ void done(const Unit&) const {}
};

__device__ __forceinline__ unsigned cvt_pk_bf16(float lo, float hi) { unsigned r; asm volatile("v_cvt_pk_bf16_f32 %0, %1, %2" : "=v"(r) : "v"(lo), "v"(hi)); return r; }

template <class Epi, class Sched, bool ALIGN_EPI = false, bool SP2 = false>
__device__ __forceinline__ void gemm_phase(PG8_LAS unsigned char* lds, const Gemm g, const Sched& S, const Epi& E) {
    const int tid = threadIdx.x, wid = __builtin_amdgcn_readfirstlane(tid >> 6), lane = tid & 63, wr = wid >> 2, wc = wid & 3, fr = lane & 15, fq = lane >> 4;
    const int K = g.K, nt = K / BK;
    unsigned voffA[2], voffB[2];
#pragma unroll
    for (int i = 0; i < 2; ++i) { int R, C; stage_rc(tid * 16 + i * 8192, R, C); const int Rb = Epi::PERM ? ((R & ~31) + perm32(R & 31)) : R;
        voffA[i] = (unsigned)(R * K + C) * 2u; voffB[i] = (unsigned)(Rb * K + C) * 2u; }
    const size_t kstep = (size_t)(BK * 2);
    const size_t hstep = (size_t)HALF * K * 2;
    const size_t tstep = 2 * hstep;
    const unsigned ldsw = (unsigned)wid * 1024u;
    const int aoff = lds_byte(wr * 64 + fr, fq * 8), boff = lds_byte(wc * 32 + fr, fq * 8);
#define PG8_SA(b, h) (((b) * 2 + (h)) * HTB)
#define PG8_SB(b, h) ((4 + (b) * 2 + (h)) * HTB)
#define PG8_STAGE(bufoff, gbase, voff) do { _Pragma("unroll") for (int _i = 0; _i < 2; ++_i) \
        __builtin_amdgcn_global_load_lds((const unsigned*)((const char*)(gbase) + (voff)[_i]), (PG8_LAS unsigned*)(lds + (bufoff) + ldsw + _i * 8192), 16, 0, 0); } while (0)
#define PG8_LDA(dst, b, h) do { _Pragma("unroll") for (int m = 0; m < 4; ++m) _Pragma("unroll") for (int k = 0; k < 2; ++k) dst[m][k] = *(const PG8_LAS bf16x8*)(lds + PG8_SA(b, h) + aoff + m * 2048 + k * 1024); } while (0)
#define PG8_LDB(dst, b, h) do { _Pragma("unroll") for (int n = 0; n < 2; ++n) _Pragma("unroll") for (int k = 0; k < 2; ++k) dst[n][k] = *(const PG8_LAS bf16x8*)(lds + PG8_SB(b, h) + boff + n * 2048 + k * 1024); } while (0)
#define PG8_MMA(ai, bj, At, Bt) do { __builtin_amdgcn_s_setprio(1); _Pragma("unroll") for (int m = 0; m < 4; ++m) _Pragma("unroll") for (int n = 0; n < 2; ++n) _Pragma("unroll") for (int k = 0; k < 2; ++k) \
        acc[ai][bj][m][n] = __builtin_amdgcn_mfma_f32_16x16x32_bf16(Bt[n][k], At[m][k], acc[ai][bj][m][n], 0, 0, 0); __builtin_amdgcn_s_setprio(0); } while (0)
#define PG8_WAIT_V(n) asm volatile("s_waitcnt vmcnt(" #n ")" ::: "memory")
#define PG8_WAIT_L(n) asm volatile("s_waitcnt lgkmcnt(" #n ")" ::: "memory")
#define PG8_BAR __builtin_amdgcn_s_barrier()
#define PG8_SCHED __builtin_amdgcn_sched_barrier(0)
    Unit cur, nxt; int ui = 0;
    if (!S.next(0, cur)) return;
    f32x4 acc[2][2][4][2];
#pragma unroll
    for (int a = 0; a < 2; ++a)
#pragma unroll
        for (int b = 0; b < 2; ++b)
#pragma unroll
            for (int m = 0; m < 4; ++m)
#pragma unroll
                for (int n = 0; n < 2; ++n) acc[a][b][m][n] = (f32x4){0.f, 0.f, 0.f, 0.f};
    bf16x8 At[4][2], B0[2][2], B1[2][2];
    const char* cA = (const char*)g.A + (size_t)cur.pm * tstep; const char* cB = (const char*)g.Bt + (size_t)cur.pn * tstep;
    S.a_ready(cur);
    if constexpr (SP2) {
        PG8_STAGE(PG8_SB(0, 0), cB, voffB); PG8_STAGE(PG8_SB(0, 1), cB + hstep, voffB); PG8_STAGE(PG8_SA(0, 0), cA, voffA); PG8_STAGE(PG8_SA(0, 1), cA + hstep, voffA);
        if (wr == 1) PG8_BAR;
        PG8_WAIT_V(2); PG8_BAR;
        PG8_STAGE(PG8_SB(1, 0), cB + kstep, voffB); PG8_STAGE(PG8_SA(1, 0), cA + kstep, voffA); PG8_STAGE(PG8_SB(1, 1), cB + hstep + kstep, voffB);
        PG8_WAIT_V(6); PG8_BAR;
    } else {
        PG8_STAGE(PG8_SB(0, 0), cB, voffB); PG8_STAGE(PG8_SA(0, 0), cA, voffA); PG8_STAGE(PG8_SB(0, 1), cB + hstep, voffB); PG8_STAGE(PG8_SA(0, 1), cA + hstep, voffA);
        if (wr == 1) PG8_BAR;
        PG8_WAIT_V(4); PG8_BAR;
        PG8_STAGE(PG8_SB(1, 0), cB + kstep, voffB); PG8_STAGE(PG8_SA(1, 0), cA + kstep, voffA); PG8_STAGE(PG8_SB(1, 1), cB + hstep + kstep, voffB);
        PG8_WAIT_V(6); PG8_BAR;
    }
    for (;;) {
        const bool has_next = S.next(ui + 1, nxt);
        const char* nA = has_next ? (const char*)g.A + (size_t)nxt.pm * tstep : cA; const char* nB = has_next ? (const char*)g.Bt + (size_t)nxt.pn * tstep : cB;
        for (int t = 0; t < nt; t += 2) {
            const bool last = (t == nt - 2);
            const char* a1 = cA + (size_t)(t + 1) * kstep;
            const char* a2 = last ? nA : cA + (size_t)(t + 2) * kstep; const char* b2 = last ? nB : cB + (size_t)(t + 2) * kstep;
            const char* a3 = a2 + kstep; const char* b3 = b2 + kstep;
            if (last && has_next) S.a_ready(nxt);
            if constexpr (SP2) {
            PG8_LDB(B0, 0, 0); PG8_LDB(B1, 0, 1); PG8_SCHED; PG8_LDA(At, 0, 0); PG8_STAGE(PG8_SA(1, 1), a1 + hstep, voffA);
            PG8_WAIT_V(8); PG8_WAIT_L(0); PG8_BAR; PG8_MMA(0, 0, At, B0); PG8_MMA(0, 1, At, B1); PG8_BAR; PG8_SCHED;
            PG8_LDA(At, 0, 1); PG8_STAGE(PG8_SB(0, 0), b2, voffB); PG8_STAGE(PG8_SB(0, 1), b2 + hstep, voffB); PG8_STAGE(PG8_SA(0, 0), a2, voffA);
            PG8_WAIT_V(8); PG8_WAIT_L(0); PG8_BAR; PG8_MMA(1, 0, At, B0); PG8_MMA(1, 1, At, B1); PG8_BAR; PG8_SCHED;
            PG8_LDB(B0, 1, 0); PG8_LDB(B1, 1, 1); PG8_SCHED; PG8_LDA(At, 1, 0); PG8_STAGE(PG8_SA(0, 1), a2 + hstep, voffA);
            PG8_WAIT_V(8); PG8_WAIT_L(0); PG8_BAR; PG8_MMA(0, 0, At, B0); PG8_MMA(0, 1, At, B1); PG8_BAR; PG8_SCHED;
            PG8_LDA(At, 1, 1); PG8_STAGE(PG8_SB(1, 0), b3, voffB); PG8_STAGE(PG8_SB(1, 1), b3 + hstep, voffB); PG8_STAGE(PG8_SA(1, 0), a3, voffA);
            PG8_WAIT_V(8); PG8_WAIT_L(0); PG8_BAR; PG8_MMA(1, 0, At, B0); PG8_MMA(1, 1, At, B1); PG8_BAR; PG8_SCHED;
            } else {
            PG8_LDB(B0, 0, 0); PG8_SCHED; PG8_LDA(At, 0, 0); PG8_STAGE(PG8_SA(1, 1), a1 + hstep, voffA);
            PG8_WAIT_L(8); PG8_BAR; PG8_WAIT_L(0); PG8_MMA(0, 0, At, B0); PG8_BAR; PG8_SCHED;
            PG8_LDB(B1, 0, 1); PG8_STAGE(PG8_SB(0, 0), b2, voffB);
            PG8_BAR; PG8_WAIT_L(0); PG8_MMA(0, 1, At, B1); PG8_BAR;
            PG8_LDA(At, 0, 1); PG8_STAGE(PG8_SA(0, 0), a2, voffA);
            PG8_BAR; PG8_WAIT_L(0); PG8_MMA(1, 0, At, B0); PG8_BAR; PG8_SCHED;
            PG8_STAGE(PG8_SB(0, 1), b2 + hstep, voffB);
            PG8_WAIT_V(6); PG8_BAR; PG8_MMA(1, 1, At, B1); PG8_BAR;
            PG8_LDB(B0, 1, 0); PG8_SCHED; PG8_LDA(At, 1, 0); PG8_STAGE(PG8_SA(0, 1), a2 + hstep, voffA);
            PG8_WAIT_L(8); PG8_BAR; PG8_WAIT_L(0); PG8_MMA(0, 0, At, B0); PG8_BAR; PG8_SCHED;
            PG8_LDB(B1, 1, 1); PG8_STAGE(PG8_SB(1, 0), b3, voffB);
            PG8_BAR; PG8_WAIT_L(0); PG8_MMA(0, 1, At, B1); PG8_BAR;
            PG8_LDA(At, 1, 1); PG8_STAGE(PG8_SA(1, 0), a3, voffA);
            PG8_BAR; PG8_WAIT_L(0); PG8_MMA(1, 0, At, B0); PG8_BAR; PG8_SCHED;
            PG8_STAGE(PG8_SB(1, 1), b3 + hstep, voffB);
            PG8_WAIT_V(6); PG8_BAR; PG8_MMA(1, 1, At, B1); PG8_BAR;
            }
        }
        if constexpr (ALIGN_EPI) { if (wr == 0) PG8_BAR; }
        if constexpr (!Epi::AFTER_DRAIN) { E(acc, cur, wr, wc, fr, fq); S.done(cur); }
        if (!has_next) break;
#pragma unroll
        for (int a = 0; a < 2; ++a)
#pragma unroll
            for (int b = 0; b < 2; ++b)
#pragma unroll
                for (int m = 0; m < 4; ++m)
#pragma unroll
                    for (int n = 0; n < 2; ++n) acc[a][b][m][n] = (f32x4){0.f, 0.f, 0.f, 0.f};
        cur = nxt; cA = nA; cB = nB; ++ui;
        if constexpr (ALIGN_EPI) { if (wr == 1) PG8_BAR; }
    }
    PG8_WAIT_V(0);
    if constexpr (!ALIGN_EPI) { if (wr == 0) PG8_BAR; }
    PG8_BAR;
    if constexpr (Epi::AFTER_DRAIN) { E.fused(acc, cur, wr, wc, fr, fq, lds, wid, lane); S.done(cur); }
#undef PG8_SA
#undef PG8_SB
#undef PG8_STAGE
#undef PG8_LDA
#undef PG8_LDB
#undef PG8_MMA
#undef PG8_WAIT_V
#undef PG8_WAIT_L
#undef PG8_BAR
#undef PG8_SCHED
}
}
namespace pg8 {
typedef unsigned u32x2 __attribute__((ext_vector_type(2)));
__device__ __forceinline__ unsigned pkbf(float a, float b) { typedef float f2 __attribute__((ext_vector_type(2))); typedef __bf16 b2 __attribute__((ext_vector_type(2)));
    f2 v = {a, b}; b2 r = __builtin_convertvector(v, b2); return __builtin_bit_cast(unsigned, r); }
template <int ACT  , bool KMAX = false, int SCALE = 0, bool TILED = false  > struct EpiB {
    static constexpr bool PERM = true, AFTER_DRAIN = false;
    bf16_t* O; int ldc; unsigned* kmax; int kpn0, kpn1; const float* ss; bf16_t* kfrag; int kfpn;
    __device__ __forceinline__ void operator()(const f32x4 (&acc)[2][2][4][2], const Unit& u, int wr, int wc, int fr, int fq) const {
        const int row0 = u.pm * BM + wr * 64 + fr; const int col0 = u.pn * BM + wc * 32 + 8 * fq;
        float rsr[2][4]; f32x4 rsc[2][2];
        if (SCALE == 1) {
#pragma unroll
            for (int ai = 0; ai < 2; ++ai)
#pragma unroll
                for (int m = 0; m < 4; ++m) rsr[ai][m] = ss[row0 + ai * HALF + m * 16]; }
        if (SCALE == 2) {
#pragma unroll
            for (int bj = 0; bj < 2; ++bj)
#pragma unroll
                for (int n = 0; n < 2; ++n) rsc[bj][n] = *(const f32x4*)(ss + col0 + bj * HALF + 4 * n); }
        if (KMAX) if (u.pn >= kpn0 && u.pn < kpn1) {
#pragma unroll
            for (int bj = 0; bj < 2; ++bj) { float mx = 0.f;
#pragma unroll
                for (int ai = 0; ai < 2; ++ai)
#pragma unroll
                    for (int m = 0; m < 4; ++m) { const f32x4 a = acc[ai][bj][m][0], b = acc[ai][bj][m][1];
                        float q = (a[0] * a[0] + a[1] * a[1]) + (a[2] * a[2] + a[3] * a[3]) + (b[0] * b[0] + b[1] * b[1]) + (b[2] * b[2] + b[3] * b[3]);
                        if (SCALE == 1) q *= rsr[ai][m] * rsr[ai][m];
                        q += __shfl_xor(q, 16); q += __shfl_xor(q, 32); mx = fmaxf(mx, q); }
                mx = fmaxf(mx, __shfl_xor(mx, 1)); mx = fmaxf(mx, __shfl_xor(mx, 2)); mx = fmaxf(mx, __shfl_xor(mx, 4)); mx = fmaxf(mx, __shfl_xor(mx, 8));
                if (fr == 0 && fq == 0) atomicMax(kmax + (u.pm >> 5) * ((kpn1 - kpn0) * 8) + (u.pn - kpn0) * 8 + bj * 4 + wc, __float_as_uint(mx)); }
        }
#pragma unroll
        for (int ai = 0; ai < 2; ++ai)
#pragma unroll
            for (int m = 0; m < 4; ++m) { bf16_t* rowp = O + (size_t)(row0 + ai * HALF + m * 16) * ldc + col0;
#pragma unroll
                for (int bj = 0; bj < 2; ++bj) { f32x4 v0 = acc[ai][bj][m][0], v1 = acc[ai][bj][m][1];
                    if (SCALE == 1) { v0 *= rsr[ai][m]; v1 *= rsr[ai][m]; }
                    if (SCALE == 2) { v0 *= rsc[bj][0]; v1 *= rsc[bj][1]; }
                    if (ACT == 1) {
#pragma unroll
                        for (int e = 0; e < 4; ++e) { float a = fmaxf(v0[e], 0.f), b = fmaxf(v1[e], 0.f); v0[e] = a * a; v1[e] = b * b; } }
                    u32x4 w; w.x = pkbf(v0[0], v0[1]); w.y = pkbf(v0[2], v0[3]); w.z = pkbf(v1[0], v1[1]); w.w = pkbf(v1[2], v1[3]);
                    if (TILED) { const int f = row0 + ai * HALF + m * 16, tok = col0 + bj * HALF, d = f & 63, q = (tok & 31) >> 3;
                        *(u32x4*)(O + ((size_t)((f >> 6) * 1024 + (tok >> 5)) * 2048) + (((((d >> 5) * 2 + (q >> 1)) * 2 + (q & 1)) * 32 + (d & 31)) * 8)) = w; }
                    else if (kfrag != nullptr && u.pn == kfpn) { const int tok = row0 + ai * HALF + m * 16, cc = wc * 32 + 8 * fq + bj * HALF, d0 = cc & 63, ky = tok & 31;
                        const int rho = 16 * (ky >> 4) + 8 * ((ky >> 2) & 1) + 4 * ((ky >> 3) & 1) + (ky & 3);
                        *(u32x4*)(kfrag + ((size_t)((cc >> 6) * 1024 + (tok >> 5)) * 2048) + (((d0 >> 4) * 64 + ((d0 >> 3) & 1) * 32 + rho) * 8)) = w; }
                    else *(u32x4*)(rowp + bj * HALF) = w; } }
    }
};
template <bool NORM> struct EpiR {
    static constexpr bool PERM = false, AFTER_DRAIN = false;
    const float* base; float* out; int ldc; bf16_t* xb; float* ss;
    __device__ __forceinline__ void operator()(const f32x4 (&acc)[2][2][4][2], const Unit& u, int wr, int wc, int fr, int fq) const {
        const int col0 = u.pn * BM + wc * 32 + 4 * fq;
#pragma unroll
        for (int ai = 0; ai < 2; ++ai)
#pragma unroll
            for (int m = 0; m < 4; ++m) { const int r = ai * HALF + wr * 64 + m * 16 + fr; const size_t off = (size_t)(u.pm * BM + r) * ldc + col0; float q = 0.f;
#pragma unroll
                for (int bj = 0; bj < 2; ++bj)
#pragma unroll
                    for (int n = 0; n < 2; ++n) { const f32x4 bs = *(const f32x4*)(base + off + bj * HALF + n * 16); const f32x4 o = bs + acc[ai][bj][m][n]; *(f32x4*)(out + off + bj * HALF + n * 16) = o;
                        if (NORM) { q += (o[0] * o[0] + o[1] * o[1]) + (o[2] * o[2] + o[3] * o[3]); u32x2 w; w.x = pkbf(o[0], o[1]); w.y = pkbf(o[2], o[3]); *(u32x2*)(xb + off + bj * HALF + n * 16) = w; } }
                if (NORM) { q += __shfl_xor(q, 16); q += __shfl_xor(q, 32); if (fq == 0) ss[(size_t)(u.pm * BM + r) * 16 + u.pn * 4 + wc] = q; } }
    }
};
template <bool NORM> struct EpiRb {
    static constexpr bool PERM = true, AFTER_DRAIN = false;
    bf16_t* xb; int ldc; float* ss;
    __device__ __forceinline__ void operator()(const f32x4 (&acc)[2][2][4][2], const Unit& u, int wr, int wc, int fr, int fq) const {
        const int col0 = u.pn * BM + wc * 32 + 8 * fq;
#pragma unroll
        for (int ai = 0; ai < 2; ++ai)
#pragma unroll
            for (int m = 0; m < 4; ++m) { const int r = ai * HALF + wr * 64 + m * 16 + fr; bf16_t* rowp = xb + (size_t)(u.pm * BM + r) * ldc + col0; float q = 0.f;
                u32x4 bw[2];
#pragma unroll
                for (int bj = 0; bj < 2; ++bj) bw[bj] = *(const u32x4*)(rowp + bj * HALF);
#pragma unroll
                for (int bj = 0; bj < 2; ++bj) { const u32x4 b = bw[bj]; const f32x4 a0 = acc[ai][bj][m][0], a1 = acc[ai][bj][m][1];
                    u32x4 w;
                    w.x = pkbf(__uint_as_float(b.x << 16) + a0[0], __uint_as_float(b.x & 0xffff0000u) + a0[1]);
                    w.y = pkbf(__uint_as_float(b.y << 16) + a0[2], __uint_as_float(b.y & 0xffff0000u) + a0[3]);
                    w.z = pkbf(__uint_as_float(b.z << 16) + a1[0], __uint_as_float(b.z & 0xffff0000u) + a1[1]);
                    w.w = pkbf(__uint_as_float(b.w << 16) + a1[2], __uint_as_float(b.w & 0xffff0000u) + a1[3]);
                    *(u32x4*)(rowp + bj * HALF) = w;
                    if (NORM) {
#pragma unroll
                        for (int e = 0; e < 4; ++e) { const float lo = __uint_as_float(w[e] << 16), hi = __uint_as_float(w[e] & 0xffff0000u); q += lo * lo + hi * hi; } } }
                if (NORM) { q += __shfl_xor(q, 16); q += __shfl_xor(q, 32); if (fq == 0) ss[(size_t)(u.pm * BM + r) * 16 + u.pn * 4 + wc] = q; } }
    }
};
}

#define DI __device__ __forceinline__
typedef unsigned short bf16_t;
typedef short bf16x8 __attribute__((ext_vector_type(8)));
typedef float f32x16 __attribute__((ext_vector_type(16)));
typedef float f32x4 __attribute__((ext_vector_type(4)));
typedef unsigned u32x4 __attribute__((ext_vector_type(4)));
typedef unsigned u32x2 __attribute__((ext_vector_type(2)));
#define MFMA32(a, b, c) __builtin_amdgcn_mfma_f32_32x32x16_bf16((a), (b), (c), 0, 0, 0)
constexpr int T_ = 32768, S_ = 8192, NBAT = 4, DM = 1024, FF = 4096;
constexpr int LDP0 = 2048, LDP1 = 2304;
constexpr float LOG2E = 1.4426950408889634f, LN2 = 0.6931471805599453f;
constexpr float C1 = 0.125f * LOG2E;
constexpr float RMS_EPS = 1e-6f;
constexpr size_t MiB = 1024 * 1024;
constexpr size_t WS_W0QK = 0, WS_W0V = 4 * MiB, WS_W0O = 6 * MiB, WS_W1A = 8 * MiB, WS_W1V = 8 * MiB + 4608 * 1024, WS_W1O = WS_W1V + 1 * MiB,
                 WS_WM1 = WS_W1O + 2 * MiB, WS_WM2 = WS_WM1 + 16 * MiB, WS_WC1 = WS_WM2 + 16 * MiB, WS_WC2 = WS_WC1 + 2 * MiB, WS_BIAS = WS_WC2 + 64 * 1024,
                 WS_KC = 50 * MiB, WS_VCT = 51 * MiB, WS_XN = 52 * MiB, WS_BIG = 116 * MiB, WS_VT = WS_BIG + 160 * MiB, WS_XB = WS_BIG + 256 * MiB, WS_SS = WS_XB + 64 * MiB, WS_RS = WS_SS + 2 * MiB, WS_KSF = WS_RS + 1 * MiB, WS_END = WS_KSF + 16 * MiB;
static_assert(WS_BIAS + 4096 <= 50 * MiB - 20480, "ws map");
constexpr int LDS_GEMM = 131072;
constexpr int LDS_BYTES = LDS_GEMM + 16;
constexpr size_t WS_BAR = 50 * MiB - 16384;
constexpr size_t WS_QCTR = WS_BAR + 13824;
constexpr size_t WS_KMX = 50 * MiB - 20480;
constexpr int WAVE_LDS = 8704;

struct Params { const float* in[21]; float* out; unsigned char* ws; int ph_lo, ph_hi; };

DI unsigned pk2(float a, float b) { return pg8::pkbf(a, b); }
DI bf16x8 ldg8(const bf16_t* p) { return *(const bf16x8*)p; }
DI float fexp2(float x) { return __builtin_amdgcn_exp2f(x); }
DI float flog2(float x) { return __builtin_amdgcn_logf(x); }
DI float bf2f(bf16_t v) { return __uint_as_float((unsigned)v << 16); }
DI bf16x8 pack8(float a0, float a1, float a2, float a3, float a4, float a5, float a6, float a7) {
    u32x4 p; p.x = pk2(a0, a1); p.y = pk2(a2, a3); p.z = pk2(a4, a5); p.w = pk2(a6, a7); return __builtin_bit_cast(bf16x8, p); }
DI void wave_lds_sync() { asm volatile("s_waitcnt lgkmcnt(0)" ::: "memory"); }
DI float wave_sum(float v) {
#pragma unroll
    for (int o = 1; o < 64; o <<= 1) v += __shfl_xor(v, o);
    return v; }
DI f32x16 zero16() { f32x16 z;
#pragma unroll
    for (int i = 0; i < 16; ++i) z[i] = 0.f;
    return z; }
DI int vfrag_off(int d, int ch) { return ((((d >> 5) * 2 + (ch >> 1)) * 2 + (ch & 1)) * 32 + (d & 31)) * 8; }
DI int krow_of(int r) { return 16 * (r >> 4) + 8 * ((r >> 2) & 1) + 4 * ((r >> 3) & 1) + (r & 3); }

DI void transpose_item(const float* W, int K, int N, int c0, int nc, bf16_t* WT, int r0, int item, float* scr, int lane, const float* gain, bool frag) {
    const int nblk = nc >> 5, kb = item / nblk, nb = item - kb * nblk, k0 = 64 * kb, n0 = 32 * nb;
    const int col = c0 + n0 + (lane & 31); const bool ok = col < N;
    const float* src = W + (size_t)(k0 + (lane >> 5)) * N + (ok ? col : c0);
    float v[32];
#pragma unroll
    for (int i = 0; i < 32; ++i) v[i] = __builtin_nontemporal_load(src + (size_t)(2 * i) * N);
    if (gain) {
        float gv[32];
#pragma unroll
        for (int i = 0; i < 32; ++i) gv[i] = gain[k0 + 2 * i + (lane >> 5)];
#pragma unroll
        for (int i = 0; i < 32; ++i) v[i] *= gv[i];
    }
#pragma unroll
    for (int i = 0; i < 32; ++i) scr[(2 * i + (lane >> 5)) * 33 + (lane & 31)] = ok ? v[i] : 0.f;
    wave_lds_sync();
    const int c = lane & 7;
#pragma unroll
    for (int j = 0; j < 4; ++j) { const int n = (lane >> 3) + 8 * j; const float* s = scr + (8 * c) * 33 + n;
        u32x4 o; o.x = pk2(s[0 * 33], s[1 * 33]); o.y = pk2(s[2 * 33], s[3 * 33]); o.z = pk2(s[4 * 33], s[5 * 33]); o.w = pk2(s[6 * 33], s[7 * 33]);
        if (frag) { const int nn = r0 + n0 + n, k = k0 + 8 * c;
            *(u32x4*)(WT + ((size_t)((k >> 4) * 8 + (nn >> 5)) * 64 + ((k >> 3) & 1) * 32 + (nn & 31)) * 8) = o; }
        else *(u32x4*)(WT + (size_t)(r0 + n0 + n) * K + k0 + 8 * c) = o; }
    wave_lds_sync();
}
struct Seg { const float* W; int K, N, c0, nc, r0; bf16_t* dst; };
DI Seg get_seg(const Params& p, int s) {
    unsigned char* ws = p.ws; Seg g;
    switch (s) {
    case 0:  g = Seg{p.in[4], 1024, 3072, 0, 1024, 0, (bf16_t*)(ws + WS_W0QK)}; break;
    case 1:  g = Seg{p.in[4], 1024, 3072, 1536, 1024, 1024, (bf16_t*)(ws + WS_W0QK)}; break;
    case 2:  g = Seg{p.in[4], 1024, 3072, 1024, 512, 0, (bf16_t*)(ws + WS_W0V)}; break;
    case 3:  g = Seg{p.in[4], 1024, 3072, 2560, 512, 512, (bf16_t*)(ws + WS_W0V)}; break;
    case 4:  g = Seg{p.in[10], 1024, 1024, 0, 1024, 0, (bf16_t*)(ws + WS_W0O)}; break;
    case 5:  g = Seg{p.in[11], 1024, 2608, 0, 1536, 0, (bf16_t*)(ws + WS_W1A)}; break;
    case 6:  g = Seg{p.in[11], 1024, 2608, 1536, 256, 1536, (bf16_t*)(ws + WS_W1A)}; break;
    case 7:  g = Seg{p.in[11], 1024, 2608, 2048, 256, 1792, (bf16_t*)(ws + WS_W1A)}; break;
    case 8:  g = Seg{p.in[11], 1024, 2608, 2560, 256, 2048, (bf16_t*)(ws + WS_W1A)}; break;
    case 9:  g = Seg{p.in[11], 1024, 2608, 1792, 256, 0, (bf16_t*)(ws + WS_W1V)}; break;
    case 10: g = Seg{p.in[11], 1024, 2608, 2304, 256, 256, (bf16_t*)(ws + WS_W1V)}; break;
    case 11: g = Seg{p.in[18], 1024, 1024, 0, 1024, 0, (bf16_t*)(ws + WS_W1O)}; break;
    case 12: g = Seg{p.in[19], 1024, 4096, 0, 4096, 0, (bf16_t*)(ws + WS_WM1)}; break;
    case 13: g = Seg{p.in[19] + (size_t)1024 * 4096, 1024, 4096, 0, 4096, 0, (bf16_t*)(ws + WS_WM1 + 8 * MiB)}; break;
    case 14: g = Seg{p.in[20], 4096, 1024, 0, 1024, 0, (bf16_t*)(ws + WS_WM2)}; break;
    case 15: g = Seg{p.in[20] + (size_t)1024 * 4096, 4096, 1024, 0, 1024, 0, (bf16_t*)(ws + WS_WM2 + 8 * MiB)}; break;
    case 16: g = Seg{p.in[13], 2048, 256, 0, 256, 0, (bf16_t*)(ws + WS_WC1)}; break;
    case 17: g = Seg{p.in[16], 2048, 256, 0, 256, 0, (bf16_t*)(ws + WS_WC1 + 1 * MiB)}; break;
    case 18: g = Seg{p.in[14], 256, 64, 0, 64, 0, (bf16_t*)(ws + WS_WC2)}; break;
    default: g = Seg{p.in[17], 256, 64, 0, 64, 0, (bf16_t*)(ws + WS_WC2 + 32 * 1024)}; break;
    }
    return g;
}
constexpr int NSEG = 20;
DI void rms_rows(const float* X, const float* g, bf16_t* obf, float* of32, int gw, int ngw, int lane) {
    f32x4 gv[4];
#pragma unroll
    for (int j = 0; j < 4; ++j) gv[j] = ((const f32x4*)g)[lane + 64 * j];
    for (int row = gw * 2; row < T_; row += ngw * 2) {
        const f32x4* xr = (const f32x4*)(X + (size_t)row * DM) + lane;
        f32x4 v[2][4]; float rstd[2];
#pragma unroll
        for (int q = 0; q < 2; ++q)
#pragma unroll
            for (int j = 0; j < 4; ++j) v[q][j] = xr[q * 256 + 64 * j];
#pragma unroll
        for (int q = 0; q < 2; ++q) { float ss = 0.f;
#pragma unroll
            for (int j = 0; j < 4; ++j) ss += (v[q][j].x * v[q][j].x + v[q][j].y * v[q][j].y) + (v[q][j].z * v[q][j].z + v[q][j].w * v[q][j].w);
            rstd[q] = rsqrtf(wave_sum(ss) * (1.f / DM) + RMS_EPS); }
#pragma unroll
        for (int q = 0; q < 2; ++q)
#pragma unroll
            for (int j = 0; j < 4; ++j) {
                const f32x4 y = v[q][j] * rstd[q] * gv[j];
                if (obf) { u32x2 w; w.x = pk2(y.x, y.y); w.y = pk2(y.z, y.w); *((u32x2*)(obf + (size_t)(row + q) * DM) + lane + 64 * j) = w; }
                if (of32) ((f32x4*)(of32 + (size_t)(row + q) * DM))[lane + 64 * j] = y;
            }
    }
}
DI void final_rows(const bf16_t* X, const float* g, float* out, int gw, int ngw, int lane) {
    f32x4 gv[4];
#pragma unroll
    for (int j = 0; j < 4; ++j) gv[j] = ((const f32x4*)g)[lane + 64 * j];
    for (int row = gw * 4; row < T_; row += ngw * 4) {
        u32x2 bw[4][4]; float rstd[4];
#pragma unroll
        for (int q = 0; q < 4; ++q)
#pragma unroll
            for (int j = 0; j < 4; ++j) bw[q][j] = __builtin_nontemporal_load((const u32x2*)(X + (size_t)(row + q) * DM) + lane + 64 * j);
#pragma unroll
        for (int q = 0; q < 4; ++q) { float ss = 0.f;
#pragma unroll
            for (int j = 0; j < 4; ++j) { const float a = __uint_as_float(bw[q][j].x << 16), b = __uint_as_float(bw[q][j].x & 0xffff0000u), c = __uint_as_float(bw[q][j].y << 16), d = __uint_as_float(bw[q][j].y & 0xffff0000u);
                ss += (a * a + b * b) + (c * c + d * d); }
            rstd[q] = rsqrtf(wave_sum(ss) * (1.f / DM) + RMS_EPS); }
#pragma unroll
        for (int q = 0; q < 4; ++q)
#pragma unroll
            for (int j = 0; j < 4; ++j) { f32x4 v; v.x = __uint_as_float(bw[q][j].x << 16); v.y = __uint_as_float(bw[q][j].x & 0xffff0000u); v.z = __uint_as_float(bw[q][j].y << 16); v.w = __uint_as_float(bw[q][j].y & 0xffff0000u);
                __builtin_nontemporal_store(v * rstd[q] * gv[j], (f32x4*)(out + (size_t)(row + q) * DM) + lane + 64 * j); }
    }
}
DI void phase_prologue(const Params& p, unsigned char* lds, int wave, int lane) {
    const int gw = blockIdx.x * 8 + wave, ngw = gridDim.x * 8;
    float* scr = (float*)(lds + wave * WAVE_LDS);
    int base = 0;
    for (int s = 0; s < NSEG; ++s) {
        const Seg g = get_seg(p, s);
        const int nit = (g.K >> 6) * (g.nc >> 5);
        int first = (gw - (base % ngw) + ngw) % ngw;
        for (int it = first; it < nit; it += ngw) transpose_item(g.W, g.K, g.N, g.c0, g.nc, g.dst, g.r0, it, scr, lane, s <= 3 ? p.in[1] : (s >= 5 && s <= 10) ? p.in[1] + DM : s == 12 ? p.in[2] : s == 13 ? p.in[2] + DM : nullptr, s == 16 || s == 17);
        base += nit;
    }
    if (blockIdx.x == 0 && wave == 0) { ((unsigned*)(p.ws + WS_KMX))[lane] = 0u; ((unsigned*)(p.ws + WS_KMX))[64 + lane] = 0u; }
    {
        bf16_t* XB = (bf16_t*)(p.ws + WS_XB); float* RSt = (float*)(p.ws + WS_RS);
        for (int row = gw * 4; row < T_; row += ngw * 4) {
            const f32x4* xr = (const f32x4*)(p.in[0] + (size_t)row * DM) + lane; f32x4 v[4][4]; float ss[4];
#pragma unroll
            for (int q = 0; q < 4; ++q)
#pragma unroll
                for (int j = 0; j < 4; ++j) v[q][j] = __builtin_nontemporal_load(xr + q * 256 + 64 * j);
#pragma unroll
            for (int q = 0; q < 4; ++q) { float a = 0.f;
#pragma unroll
                for (int j = 0; j < 4; ++j) a += (v[q][j].x * v[q][j].x + v[q][j].y * v[q][j].y) + (v[q][j].z * v[q][j].z + v[q][j].w * v[q][j].w);
                ss[q] = wave_sum(a); }
#pragma unroll
            for (int q = 0; q < 4; ++q) {
#pragma unroll
                for (int j = 0; j < 4; ++j) { u32x2 w; w.x = pk2(v[q][j].x, v[q][j].y); w.y = pk2(v[q][j].z, v[q][j].w); *((u32x2*)(XB + (size_t)(row + q) * DM) + lane + 64 * j) = w; }
                if (lane == 0) RSt[row + q] = rsqrtf(ss[q] * (1.f / DM) + RMS_EPS); }
        }
    }
    for (int ob = gw; ob < 512; ob += ngw) {
        const int kv = ob >> 8, j = ob & 255; const float* pos = kv ? p.in[15] : p.in[12]; const float* w1 = kv ? p.in[16] : p.in[13];
        float a = 0.f;
        for (int i = 0; i < 32; ++i) { const int k = lane + 64 * i; a += pos[k] * w1[(size_t)k * 256 + j]; }
        a = wave_sum(a);
        if (lane == 0) ((float*)(p.ws + WS_BIAS))[ob] = a;
    }
}

DI void softmax_tile(f32x16& s, float& m, float& l, float& alpha) {
    float mt = fmaxf(fmaxf(s[0], s[1]), fmaxf(s[2], s[3]));
#pragma unroll
    for (int j = 4; j < 16; j += 4) mt = fmaxf(mt, fmaxf(fmaxf(s[j], s[j + 1]), fmaxf(s[j + 2], s[j + 3])));
    mt = fmaxf(mt, __shfl_xor(mt, 32));
    const float mn = fmaxf(m, mt); alpha = fexp2(m - mn); m = mn;
    float sum = 0.f;
#pragma unroll
    for (int j = 0; j < 16; ++j) { s[j] = fexp2(s[j] - mn); sum += s[j]; }
    l = l * alpha + sum;
}
DI bool soft_core(f32x16& s, float base, float slope2, bool boundary, int tmk8, int wlim, float& mref, bool& seen, float& l, float& alpha) {
    const float b0 = base - mref;
#pragma unroll
    for (int j = 0; j < 16; ++j) s[j] = fmaf(s[j], C1, fmaf(slope2, (float)(16 * (j >> 3) + (j & 7)), b0));
    if (boundary) {
#pragma unroll
        for (int j = 0; j < 16; ++j) { const int d = tmk8 - (16 * (j >> 3) + (j & 7)); s[j] = (d >= 0 && d < wlim) ? s[j] : -INFINITY; }
    }
    float mt = fmaxf(fmaxf(s[0], s[1]), fmaxf(s[2], s[3]));
#pragma unroll
    for (int j = 4; j < 16; j += 4) mt = fmaxf(mt, fmaxf(fmaxf(s[j], s[j + 1]), fmaxf(s[j + 2], s[j + 3])));
    mt = fmaxf(mt, __shfl_xor(mt, 32));
    const bool valid = mt > -1e30f, rebase = (mt > 8.f) || (!seen && valid);
    const bool any = __any(rebase);
    alpha = 1.f;
    if (any) {
        const float delta = rebase ? mt : 0.f;
#pragma unroll
        for (int j = 0; j < 16; ++j) s[j] -= delta;
        alpha = seen ? fexp2(-delta) : 1.f; mref += delta; l *= alpha;
    }
    seen = seen || valid;
    float sum = 0.f;
#pragma unroll
    for (int j = 0; j < 16; ++j) { s[j] = fexp2(s[j]); sum += s[j]; }
    l += sum;
    return any;
}
DI void soft_tile64(const bf16_t* ktile, const bf16_t* vtile, const bf16x8 (&qf)[4], int tmk, int wlim, bool colok, bool boundary, float slope2,
                    int lane, int hf, float& m, bool& seen, float& l, f32x16& o0, f32x16& o1) {
    const bf16_t* kr = ktile + lane * 8; const bf16_t* vr = vtile + lane * 8;
    f32x16 s = zero16();
#pragma unroll
    for (int ks = 0; ks < 4; ++ks) s = MFMA32(ldg8(kr + ks * 512), qf[ks], s);
    const bf16x8 va = ldg8(vr), vc = ldg8(vr + 512), vb = ldg8(vr + 1024), vd = ldg8(vr + 1536);
    float alpha;
    if (soft_core(s, colok ? -slope2 * (float)(tmk - 8 * hf) : -INFINITY, slope2, boundary, tmk - 8 * hf, wlim, m, seen, l, alpha)) { o0 *= alpha; o1 *= alpha; }
    const bf16x8 p0 = pack8(s[0], s[1], s[2], s[3], s[4], s[5], s[6], s[7]), p1 = pack8(s[8], s[9], s[10], s[11], s[12], s[13], s[14], s[15]);
    o0 = MFMA32(va, p0, o0); o1 = MFMA32(vb, p0, o1);
    o0 = MFMA32(vc, p1, o0); o1 = MFMA32(vd, p1, o1);
}
DI void store_o64(bf16_t* orow, const f32x16& o0, const f32x16& o1, int hf) {
#pragma unroll
    for (int q = 0; q < 4; ++q) {
        u32x2 w; w.x = pk2(o0[4 * q], o0[4 * q + 1]); w.y = pk2(o0[4 * q + 2], o0[4 * q + 3]); *(u32x2*)(orow + 8 * q + 4 * hf) = w;
        u32x2 x; x.x = pk2(o1[4 * q], o1[4 * q + 1]); x.y = pk2(o1[4 * q + 2], o1[4 * q + 3]); *(u32x2*)(orow + 32 + 8 * q + 4 * hf) = x;
    }
}

DI void sb_wave(const bf16_t* QK, const bf16_t* VT, bf16_t* O, int b, int h, int tq0, int lane) {
    const int r = lane & 31, hf = lane >> 5, krow = krow_of(r), t = tq0 + r;
    const bf16_t* qp = QK + (size_t)(b * S_ + t) * LDP0 + h * 64 + 8 * hf;
    bf16x8 qf[4];
#pragma unroll
    for (int ks = 0; ks < 4; ++ks) qf[ks] = ldg8(qp + 16 * ks);
    f32x16 o0 = zero16(), o1 = zero16();
    float R = 0.f;
    for (int kb = tq0; kb >= 0; kb -= 32) {
        const bf16_t* kr = QK + (size_t)(b * S_ + kb + krow) * LDP0 + 512 + h * 64 + 8 * hf;
        f32x16 s = zero16();
#pragma unroll
        for (int ks = 0; ks < 4; ++ks) s = MFMA32(ldg8(kr + 16 * ks), qf[ks], s);
        const int tmk = t - kb;
        f32x16 lr;
        float sumLo = 0.f, sumHi = 0.f;
#pragma unroll
        for (int j = 0; j < 16; ++j) {
            const float z = s[j] * 0.125f;
            const bool valid = (tmk - (16 * (j >> 3) + 8 * hf + (j & 7))) > 0;
            const float sp = fmaxf(z, 0.f) + flog2(1.f + fexp2(-fabsf(z) * LOG2E)) * LN2;
            lr[j] = valid ? -sp : 0.f;
            s[j] = valid ? z - sp : -INFINITY;
            if (j < 8) sumLo += lr[j]; else sumHi += lr[j];
        }
        const float pLo = __shfl_xor(sumLo, 32), pHi = __shfl_xor(sumHi, 32);
        float run = R + (hf == 0 ? pHi : 0.f);
#pragma unroll
        for (int j = 15; j >= 8; --j) { const float tl = run; run += lr[j]; s[j] = fexp2((s[j] + tl) * LOG2E); }
        run = R + sumHi + pHi + (hf == 0 ? pLo : 0.f);
#pragma unroll
        for (int j = 7; j >= 0; --j) { const float tl = run; run += lr[j]; s[j] = fexp2((s[j] + tl) * LOG2E); }
        R += (sumLo + sumHi) + (pLo + pHi);
        const bf16x8 p0 = pack8(s[0], s[1], s[2], s[3], s[4], s[5], s[6], s[7]), p1 = pack8(s[8], s[9], s[10], s[11], s[12], s[13], s[14], s[15]);
        const bf16_t* vt_ = VT + ((size_t)h * 1024 + (size_t)((b * S_ + kb) >> 5)) * 2048 + lane * 8;
        o0 = MFMA32(ldg8(vt_), p0, o0); o1 = MFMA32(ldg8(vt_ + 1024), p0, o1);
        o0 = MFMA32(ldg8(vt_ + 512), p1, o0); o1 = MFMA32(ldg8(vt_ + 1536), p1, o1);
        if (__all(R < -110.f)) break;
    }
    store_o64(O + (size_t)(b * S_ + t) * DM + h * 64, o0, o1, hf);
}

constexpr int DF_KB = 32 * 144, DF_VOFF = 2 * DF_KB, DF_BUF = DF_VOFF + 128 * 80, DF_STEP = 2 * DF_BUF  , DF_FLAGS = 2 * DF_STEP, DF_QIDX = DF_FLAGS + 64, DF_X = 0  ;
DI void diff_block(const bf16_t* QK, const bf16_t* VT, bf16_t* O, const float* subln, const unsigned* kmx, float lam, int b, int h, int tqb, int wave, int lane, unsigned char* lds) {
    const int tid = wave * 64 + lane, qs = wave & 3, c = wave >> 2;
    const int r = lane & 31, hf = lane >> 5, krow = krow_of(r), tq0 = tqb + 32 * qs, t = tq0 + r;
    const float slope2 = exp2f(-2.0f * (float)(h + 1)) * LOG2E;
    const int kc_ = tid >> 8, kkey = (tid >> 3) & 31, kch = tid & 7;
    const bf16_t* kg = QK + (size_t)(b * S_ + kkey) * LDP0 + 1536 + (h * 2 + kc_) * 64 + kch * 8;
    const int klds = kc_ * DF_KB + kkey * 144 + kch * 16;
    const int vd = tid >> 2, vch = tid & 3;
    const bf16_t* vg = VT + ((size_t)(8 + 2 * h + (vd >> 6)) * 1024 + (size_t)(b * S_ >> 5)) * 2048 + vfrag_off(vd & 63, vch);
    const int vlds = DF_VOFF + vd * 80 + vch * 16;
    const int kfo = c * DF_KB + krow * 144 + hf * 16, vfo = DF_VOFF + r * 80 + hf * 16;
    bf16x8 qf[4];
#pragma unroll
    for (int ks = 0; ks < 4; ++ks) qf[ks] = ldg8(QK + (size_t)(b * S_ + t) * LDP0 + 1024 + (h * 2 + c) * 64 + 8 * hf + 16 * ks);
    f32x16 o[4];
#pragma unroll
    for (int dt = 0; dt < 4; ++dt) o[dt] = zero16();
    float m = 0.f, l = 0.f; bool seen = false;
    float ub; { float qq = 0.f;
#pragma unroll
        for (int ks = 0; ks < 4; ++ks)
#pragma unroll
            for (int e = 0; e < 8; ++e) { const float v = bf2f((bf16_t)qf[ks][e]); qq += v * v; }
        qq += __shfl_xor(qq, 32);
        const float k2 = __uint_as_float(__hip_atomic_load(kmx + b * 16 + (h * 2 + c) * 2, __ATOMIC_RELAXED, __HIP_MEMORY_SCOPE_AGENT)) + __uint_as_float(__hip_atomic_load(kmx + b * 16 + (h * 2 + c) * 2 + 1, __ATOMIC_RELAXED, __HIP_MEMORY_SCOPE_AGENT));
        ub = sqrtf(qq * k2 * 1.02f) * C1; }
    volatile unsigned* flags = (volatile unsigned*)(lds + DF_FLAGS);
    int kb = tqb + 64; int itn = 0;
    u32x4 kreg[2], vreg[2];
#pragma unroll
    for (int j = 0; j < 2; ++j) { kreg[j] = *(const u32x4*)(kg + (size_t)(kb + 32 * j) * LDP0); vreg[j] = *(const u32x4*)(vg + (size_t)((kb + 32 * j) >> 5) * 2048); }
#pragma unroll
    for (int j = 0; j < 2; ++j) { *(u32x4*)(lds + j * DF_BUF + klds) = kreg[j]; *(u32x4*)(lds + j * DF_BUF + vlds) = vreg[j]; }
    __syncthreads();
    int cur = 0;
#pragma unroll 1
    for (; kb >= 0; kb -= 64) {
        const bool more = kb > 0;
        if (more) {
#pragma unroll
            for (int j = 0; j < 2; ++j) { kreg[j] = *(const u32x4*)(kg + (size_t)(kb - 64 + 32 * j) * LDP0); vreg[j] = *(const u32x4*)(vg + (size_t)((kb - 64 + 32 * j) >> 5) * 2048); } }
        const unsigned char* B0 = lds + cur * DF_STEP; const unsigned char* B1 = B0 + DF_BUF;
        const bool a0 = kb <= tq0, a1 = kb + 32 <= tq0;
        if (a0) {
            f32x16 s1 = zero16(), s0 = zero16();
            if (a1) {
#pragma unroll
                for (int ks = 0; ks < 4; ++ks) s1 = MFMA32(*(const bf16x8*)(B1 + kfo + ks * 32), qf[ks], s1); }
#pragma unroll
            for (int ks = 0; ks < 4; ++ks) s0 = MFMA32(*(const bf16x8*)(B0 + kfo + ks * 32), qf[ks], s0);
            float alpha;
            if (a1) {
                const int tmk = t - kb - 32;
                if (soft_core(s1, -slope2 * (float)(tmk - 8 * hf), slope2, kb + 32 == tq0, tmk - 8 * hf, 1 << 30, m, seen, l, alpha)) {
#pragma unroll
                    for (int dt = 0; dt < 4; ++dt) o[dt] *= alpha; }
                const bf16x8 p0 = pack8(s1[0], s1[1], s1[2], s1[3], s1[4], s1[5], s1[6], s1[7]), p1 = pack8(s1[8], s1[9], s1[10], s1[11], s1[12], s1[13], s1[14], s1[15]);
#pragma unroll
                for (int dt = 0; dt < 4; ++dt) { o[dt] = MFMA32(*(const bf16x8*)(B1 + vfo + dt * (32 * 80)), p0, o[dt]); o[dt] = MFMA32(*(const bf16x8*)(B1 + vfo + dt * (32 * 80) + 32), p1, o[dt]); }
            }
            {
                const int tmk = t - kb;
                if (soft_core(s0, -slope2 * (float)(tmk - 8 * hf), slope2, kb == tq0, tmk - 8 * hf, 1 << 30, m, seen, l, alpha)) {
#pragma unroll
                    for (int dt = 0; dt < 4; ++dt) o[dt] *= alpha; }
                const bf16x8 p0 = pack8(s0[0], s0[1], s0[2], s0[3], s0[4], s0[5], s0[6], s0[7]), p1 = pack8(s0[8], s0[9], s0[10], s0[11], s0[12], s0[13], s0[14], s0[15]);
#pragma unroll
                for (int dt = 0; dt < 4; ++dt) { o[dt] = MFMA32(*(const bf16x8*)(B0 + vfo + dt * (32 * 80)), p0, o[dt]); o[dt] = MFMA32(*(const bf16x8*)(B0 + vfo + dt * (32 * 80) + 32), p1, o[dt]); }
            }
        }
        if (more) { unsigned char* N = lds + (cur ^ 1) * DF_STEP;
#pragma unroll
            for (int j = 0; j < 2; ++j) { *(u32x4*)(N + j * DF_BUF + klds) = kreg[j]; *(u32x4*)(N + j * DF_BUF + vlds) = vreg[j]; } }
        { const bool mine = seen && (ub - slope2 * (float)(t - kb + 1) - m < -150.f);
          const bool dn = a0 && __all(mine);
          if (lane == 0) flags[(itn & 1) * 8 + wave] = dn ? 1u : 0u; }
        __syncthreads();
        cur ^= 1;
        { const volatile unsigned* f = flags + (itn & 1) * 8; const unsigned a = f[0] & f[1] & f[2] & f[3] & f[4] & f[5] & f[6] & f[7]; ++itn; if (a) break; }
    }
    l += __shfl_xor(l, 32);
    float* X = (float*)(lds + DF_X) + qs * 4096 + lane;
    if (c == 1) { const float i1 = lam / l;
#pragma unroll
        for (int dt = 0; dt < 4; ++dt)
#pragma unroll
            for (int j = 0; j < 16; ++j) X[(dt * 16 + j) * 64] = o[dt][j] * i1; }
    __syncthreads();
    if (c == 0) {
        const float i0 = 1.f / l; float ss = 0.f;
#pragma unroll
        for (int dt = 0; dt < 4; ++dt)
#pragma unroll
            for (int j = 0; j < 16; ++j) { const float v = o[dt][j] * i0 - X[(dt * 16 + j) * 64]; o[dt][j] = v; ss += v * v; }
        ss += __shfl_xor(ss, 32);
        const float rs = rsqrtf(ss * (1.f / 128.f) + RMS_EPS) * 0.8f;
        bf16_t* orow = O + (size_t)(b * S_ + t) * DM + 512 + h * 128;
#pragma unroll
        for (int dt = 0; dt < 4; ++dt)
#pragma unroll
            for (int q = 0; q < 4; ++q) { const int d = 32 * dt + 8 * q + 4 * hf; const f32x4 gsub = *(const f32x4*)(subln + d);
                u32x2 w; w.x = pk2(o[dt][4 * q] * rs * gsub.x, o[dt][4 * q + 1] * rs * gsub.y); w.y = pk2(o[dt][4 * q + 2] * rs * gsub.z, o[dt][4 * q + 3] * rs * gsub.w);
                *(u32x2*)(orow + d) = w; }
    }
}
DI void phase_attn0(const Params& p, unsigned char* lds, int wave, int lane, int rep = 0) {
    const bf16_t* QK = (const bf16_t*)(p.ws + WS_BIG); const bf16_t* VT = (const bf16_t*)(p.ws + WS_VT); bf16_t* O = (bf16_t*)(p.ws + WS_XN);
    const float d1 = wave_sum(p.in[5][lane] * p.in[6][lane]), d2 = wave_sum(p.in[7][lane] * p.in[8][lane]);
    const float lam = expf(d1) - expf(d2) + 0.2f;
    {
        unsigned* qctr = (unsigned*)(p.ws + WS_QCTR) + rep;
        volatile unsigned* qidx = (volatile unsigned*)(lds + DF_QIDX);
        for (;;) {
            if (threadIdx.x == 0) qidx[0] = atomicAdd(qctr, 1u);
            __syncthreads();
            const unsigned idx = qidx[0];
            __syncthreads();
            if (idx >= 1024u) break;
            const int bh = idx & 15, qt = 63 - (int)(idx >> 4);
            diff_block(QK, VT, O, p.in[9], (const unsigned*)(p.ws + WS_KMX), lam, bh >> 2, bh & 3, qt * 128, wave, lane, lds);
        }
    }
#pragma nounroll
    for (int rep = 0; rep < (PROBE_DUP == 22 ? 2 : 1); ++rep)
    for (int idx = blockIdx.x; idx < 1024; idx += gridDim.x) {
        const int bh = idx >> 5, qt = idx & 31;
        sb_wave(QK, VT, O, bh >> 3, bh & 7, qt * 256 + wave * 32, lane);
    }
}

DI float gelu_tanh(float x) { const float u = 0.7978845608028654f * (x + 0.044715f * x * x * x); const float e = fexp2(2.f * LOG2E * u); return 0.5f * x * (2.f - 2.f / (e + 1.f)); }
DI void phase_compress(const Params& p, unsigned char* lds, int wave, int lane) {
    const bf16_t* P1 = (const bf16_t*)(p.ws + WS_BIG);
    bf16_t* H = (bf16_t*)lds;
    const int r = lane & 31, hf = lane >> 5;
    for (int u = blockIdx.x; u < 512; u += gridDim.x) {
        const int kv = u >> 8, b = (u >> 6) & 3, g = (u >> 4) & 3, it = u & 15, i0 = 32 * it;
        const bf16_t* W1 = (const bf16_t*)(p.ws + WS_WC1 + (size_t)kv * MiB); const bf16_t* W2 = (const bf16_t*)(p.ws + WS_WC2 + (size_t)kv * 32 * 1024);
        const float* bias = (const float*)(p.ws + WS_BIAS) + kv * 256;
        unsigned char* AL = lds + 17408;
        { const bf16_t* src = P1 + (size_t)(b * S_) * LDP1 + 1024 + kv * 256 + g * 64;
          u32x4 tmp[9];
#pragma unroll
          for (int j = 0; j < 9; ++j) { const int c = min((int)threadIdx.x + 512 * j, 528 * 8 - 1), tl = c >> 3, ch = c & 7; const int tok = min(16 * i0 + tl, S_ - 1);
              tmp[j] = *(const u32x4*)(src + (size_t)tok * LDP1 + ch * 8); }
#pragma unroll
          for (int j = 0; j < 9; ++j) { const int c = (int)threadIdx.x + 512 * j, tl = c >> 3, ch = c & 7;
              if (c < 528 * 8) *(u32x4*)(AL + tl * 128 + (tl >> 7) * 128 + ((ch ^ ((tl >> 4) & 7)) << 4)) = tmp[j]; } }
        __syncthreads();
        const bf16_t* bp = W1 + (size_t)wave * 512 + lane * 8;
        f32x16 acc = zero16();
        bf16x8 rb[4][8];
#pragma unroll
        for (int gq = 0; gq < 4; ++gq)
#pragma unroll
            for (int u8 = 0; u8 < 8; ++u8) rb[gq][u8] = ldg8(bp + (size_t)(gq * 8 + u8) * 4096);
#pragma unroll 1
        for (int k0 = 0; k0 < 128; k0 += 32) {
#pragma unroll
            for (int gq = 0; gq < 4; ++gq) {
#pragma unroll
                for (int u8 = 0; u8 < 8; ++u8) { const int kk = k0 + gq * 8 + u8; const int tl = 16 * r + (kk >> 2), ch = 2 * (kk & 3) + hf;
                    acc = MFMA32(*(const bf16x8*)(AL + tl * 128 + (tl >> 7) * 128 + ((ch ^ ((tl >> 4) & 7)) << 4)), rb[gq][u8], acc); }
                if (k0 + 32 < 128) {
#pragma unroll
                    for (int u8 = 0; u8 < 8; ++u8) rb[gq][u8] = ldg8(bp + (size_t)(k0 + 32 + gq * 8 + u8) * 4096); }
            }
        }
        const float bj = bias[32 * wave + r];
#pragma unroll
        for (int j = 0; j < 16; ++j) { const int row = (j & 3) + 8 * (j >> 2) + 4 * hf; const float hval = gelu_tanh(acc[j] + bj);
            H[row * 264 + 32 * wave + r] = (bf16_t)(pk2(hval, 0.f) & 0xffffu); }
        __syncthreads();
        if (wave < 2) {
            f32x16 a2 = zero16();
            const bf16_t* hp = H + r * 264 + 8 * hf; const bf16_t* wp = W2 + (size_t)(32 * wave + r) * 256 + 8 * hf;
#pragma unroll
            for (int k2 = 0; k2 < 16; ++k2) a2 = MFMA32(*(const bf16x8*)(hp + 16 * k2), ldg8(wp + 16 * k2), a2);
            const int d = 32 * wave + r;
            if (kv == 0) {
                float mx = 0.f;
#pragma unroll
                for (int j = 0; j < 16; ++j) { float q = a2[j] * a2[j]; q += __shfl_xor(q, 1); q += __shfl_xor(q, 2); q += __shfl_xor(q, 4); q += __shfl_xor(q, 8); q += __shfl_xor(q, 16); mx = fmaxf(mx, q); }
                mx = fmaxf(mx, __shfl_xor(mx, 32));
                if (lane == 0) atomicMax((unsigned*)(p.ws + WS_KMX) + 96 + (b * 4 + g) * 2 + wave, __float_as_uint(mx)); }
            if (kv == 0) { bf16_t* kc = (bf16_t*)(p.ws + WS_KC) + (size_t)((b * 4 + g) * 512) * 64;
#pragma unroll
                for (int j = 0; j < 16; ++j) { const int i = i0 + (j & 3) + 8 * (j >> 2) + 4 * hf; kc[(size_t)i * 64 + d] = i < 511 ? (bf16_t)(pk2(a2[j], 0.f) & 0xffffu) : (bf16_t)0; }
            } else { bf16_t* vct = (bf16_t*)(p.ws + WS_VCT) + ((size_t)((b * 4 + g) * 16 + it) * 64 + d) * 32 - i0;
#pragma unroll
                for (int q = 0; q < 8; ++q) { const int j = (q >> 1) * 4 + (q & 1) * 2; const int i = i0 + (j & 3) + 8 * (j >> 2) + 4 * hf;
                    const float lo = a2[j], hi = (i + 1 < 511) ? a2[j + 1] : 0.f; *(unsigned*)(vct + i) = pk2(lo, hi); }
            }
        }
        __syncthreads();
    }
}

constexpr int NS_VOFF = 4608, NS_BUF = 9728, NS_BASE = 8 * WAVE_LDS;
DI f32x16 qk_lds(const unsigned char* B, const bf16x8 (&qf)[4], int krow, int hf) {
    f32x16 s = zero16();
#pragma unroll
    for (int ks = 0; ks < 4; ++ks) s = MFMA32(*(const bf16x8*)(B + krow * 144 + hf * 16 + ks * 32), qf[ks], s);
    return s; }
DI void pv_lds(const unsigned char* B, const bf16x8& p0, const bf16x8& p1, f32x16& o0, f32x16& o1, int r, int hf) {
    const unsigned char* v = B + NS_VOFF + r * 80 + hf * 16;
    o0 = MFMA32(*(const bf16x8*)(v), p0, o0); o1 = MFMA32(*(const bf16x8*)(v + 32 * 80), p0, o1);
    o0 = MFMA32(*(const bf16x8*)(v + 32), p1, o0); o1 = MFMA32(*(const bf16x8*)(v + 32 * 80 + 32), p1, o1); }
DI void nsa_block(const bf16_t* P1, const bf16_t* VT1, const bf16_t* KSF, const bf16_t* KC, const bf16_t* VCT, bf16_t* O, const unsigned* kmx, int b, int g, int t0b, int wave, int lane, unsigned char* lds) {
    unsigned char* wl = lds + wave * WAVE_LDS; unsigned char* SB = lds + NS_BASE;
    const int t0w = t0b + 8 * wave, tid = wave * 64 + lane;
    const bool kst = wave < 4;
    const int st_row = kst ? (tid >> 3) : ((tid - 256) >> 2), st_ch = kst ? (tid & 7) : ((tid - 256) & 3);
    const int st_dst = kst ? st_row * 144 + st_ch * 16 : NS_VOFF + st_row * 80 + st_ch * 16;
    u32x4 sreg = {0u, 0u, 0u, 0u};
    float* impA = (float*)wl; float* impB = impA + 1024; unsigned long long* selm = (unsigned long long*)(wl + 8192);
    const int r = lane & 31, hf = lane >> 5, tk = r >> 2, hh = r & 3, krow = krow_of(r);
    const int t = t0w + tk, head = g * 4 + hh, tmax = t0w + 7;
    const float slope2 = exp2f(-0.5f * (float)(head + 1)) * LOG2E;
    const bf16_t* prow = P1 + (size_t)(b * S_ + t) * LDP1;
    bf16x8 qf[4];
#pragma unroll
    for (int ks = 0; ks < 4; ++ks) qf[ks] = ldg8(prow + head * 64 + 8 * hf + 16 * ks);
    const float gc = 1.f / (1.f + __expf(-bf2f(prow[2048 + head * 3 + 0]))), gs = 1.f / (1.f + __expf(-bf2f(prow[2048 + head * 3 + 1]))), gwn = 1.f / (1.f + __expf(-bf2f(prow[2048 + head * 3 + 2])));
#pragma unroll
    for (int i = 0; i < 16; ++i) { impA[lane + 64 * i] = 0.f; impB[lane + 64 * i] = 0.f; }
    wave_lds_sync();
    const int nmax = tmax >= 31 ? ((tmax - 31) >> 4) + 1 : 0, ntile = (nmax + 31) >> 5;
    const bf16_t* kcb = KC + (size_t)((b * 4 + g) * 512) * 64;
    const bf16_t* vcb = VCT + (size_t)((b * 4 + g) * 64) * 512;
    int lo_b = 0, lo_w = 0;
    { float qq = 0.f;
#pragma unroll
      for (int ks = 0; ks < 4; ++ks)
#pragma unroll
          for (int e = 0; e < 8; ++e) { const float v = bf2f((bf16_t)qf[ks][e]); qq += v * v; }
      qq += __shfl_xor(qq, 32);
      const unsigned* kcm = kmx + 96 + (b * 4 + g) * 2;
      const float kc2 = __uint_as_float(__hip_atomic_load(kcm, __ATOMIC_RELAXED, __HIP_MEMORY_SCOPE_AGENT)) + __uint_as_float(__hip_atomic_load(kcm + 1, __ATOMIC_RELAXED, __HIP_MEMORY_SCOPE_AGENT));
      const float ubc = sqrtf(qq * kc2 * 1.02f) * C1;
      const float Dcol = (150.f + 2.f * ubc) / slope2 + 15.f;
      const float f = (((float)(t - 31) - Dcol) * (1.f / 16.f) - 31.f) * (1.f / 32.f);
      int lo = f > 0.f ? (int)floorf(f) : 0;
#pragma unroll
      for (int o = 1; o < 64; o <<= 1) lo = min(lo, __shfl_xor(lo, o));
      lo_w = lo;
      volatile int* xl = (volatile int*)(SB + 2 * NS_BUF + 64);
      if (lane == 0) xl[wave] = lo_w;
      __syncthreads();
      lo_b = min(min(min(xl[0], xl[1]), min(xl[2], xl[3])), min(min(xl[4], xl[5]), min(xl[6], xl[7]))); }
    float m = -1e30f, l = 0.f;
    const int tmaxb = t0b + 63, ntb = ((tmaxb >= 31 ? ((tmaxb - 31) >> 4) + 1 : 0) + 31) >> 5;
#define NS_CMP_SRC(n) (kst ? kcb + (size_t)(32 * (n) + st_row) * 64 + st_ch * 8 : vcb + (size_t)(n) * 2048 + st_row * 32 + st_ch * 8)
    if (ntb > lo_b) {
        if (kst) sreg = *(const u32x4*)NS_CMP_SRC(lo_b);
        if (kst) *(u32x4*)(SB + st_dst) = sreg;
        __syncthreads();
#pragma unroll 1
        for (int it = lo_b; it < ntb; ++it) {
            if (kst && it + 1 < ntb) sreg = *(const u32x4*)NS_CMP_SRC(it + 1);
            const unsigned char* B = SB + ((it - lo_b) & 1) * NS_BUF;
            if (it >= lo_w && it < ntile) {
                const int ib = 32 * it;
                f32x16 s = qk_lds(B, qf, krow, hf);
#pragma unroll
                for (int j = 0; j < 16; ++j) { const int dist = t - 31 - 16 * (ib + 16 * (j >> 3) + 8 * hf + (j & 7)); s[j] = dist >= 0 ? s[j] * C1 - slope2 * (float)dist : -INFINITY; }
                float alpha; softmax_tile(s, m, l, alpha);
            }
            if (kst && it + 1 < ntb) *(u32x4*)(SB + ((it + 1 - lo_b) & 1) * NS_BUF + st_dst) = sreg;
            __syncthreads();
        }
    }
    l += __shfl_xor(l, 32);
    const float inv = (t >= 31) ? 1.f / l : 0.f;
    f32x16 of0 = zero16(), of1 = zero16();
    if (ntb > lo_b) {
        sreg = *(const u32x4*)NS_CMP_SRC(lo_b);
        *(u32x4*)(SB + st_dst) = sreg;
        __syncthreads();
    }
#pragma unroll 1
    for (int it = lo_b; it < ntb; ++it) {
        if (it + 1 < ntb) sreg = *(const u32x4*)NS_CMP_SRC(it + 1);
        const unsigned char* B = SB + ((it - lo_b) & 1) * NS_BUF;
        if (it >= lo_w && it < ntile) {
        const int ib = 32 * it;
        f32x16 s = qk_lds(B, qf, krow, hf);
#pragma unroll
        for (int j = 0; j < 16; ++j) { const int dist = t - 31 - 16 * (ib + 16 * (j >> 3) + 8 * hf + (j & 7)); s[j] = dist >= 0 ? fexp2(s[j] * C1 - slope2 * (float)dist - m) * inv : 0.f; }
#pragma unroll
        for (int q = 0; q < 4; ++q) {
            float gsum = (s[4 * q] + s[4 * q + 1]) + (s[4 * q + 2] + s[4 * q + 3]), e = s[4 * q + 3];
            gsum += __shfl_xor(gsum, 1); gsum += __shfl_xor(gsum, 2); e += __shfl_xor(e, 1); e += __shfl_xor(e, 2);
            const int ssel = (ib >> 2) + 4 * (q >> 1) + 2 * hf + (q & 1);
            if (hh == 0) { impA[tk * 128 + ssel] = gsum; if (ssel + 1 < 128) impB[tk * 128 + ssel + 1] = e; }
        }
        const bf16x8 p0 = pack8(s[0], s[1], s[2], s[3], s[4], s[5], s[6], s[7]), p1 = pack8(s[8], s[9], s[10], s[11], s[12], s[13], s[14], s[15]);
        pv_lds(B, p0, p1, of0, of1, r, hf);
        }
        if (it + 1 < ntb) *(u32x4*)(SB + ((it + 1 - lo_b) & 1) * NS_BUF + st_dst) = sreg;
        __syncthreads();
    }
#undef NS_CMP_SRC
    of0 *= gc; of1 *= gc;
    wave_lds_sync();
    const unsigned long long lt_mask = (1ull << lane) - 1ull;
    for (int k2 = 0; k2 < 8; ++k2) {
        const int cur = (t0w + k2) >> 6;
        unsigned long long ma, mb;
        if (cur < 16) { ma = __ballot(lane <= cur); mb = 0ull; }
        else {
            const float va = impA[k2 * 128 + lane] + impB[k2 * 128 + lane], vb = impA[k2 * 128 + 64 + lane] + impB[k2 * 128 + 64 + lane];
            const int sa = lane, sb = lane + 64;
            const unsigned ka = (sa >= 1 && sa <= cur - 2) ? __float_as_uint(va) + 1u : 0u, kb = (sb <= cur - 2) ? __float_as_uint(vb) + 1u : 0u;
            unsigned tau = 0u;
            for (int bit = 31; bit >= 0; --bit) { const unsigned trial = tau | (1u << bit);
                const int cnt = __popcll(__ballot(ka >= trial)) + __popcll(__ballot(kb >= trial)); if (cnt >= 13) tau = trial; }
            const unsigned long long eqA = __ballot(ka == tau), eqB = __ballot(kb == tau);
            const int need = 13 - __popcll(__ballot(ka > tau)) - __popcll(__ballot(kb > tau));
            const int rankA = __popcll(eqA & lt_mask), rankB = __popcll(eqA) + __popcll(eqB & lt_mask);
            const bool selA = (ka > tau) || (ka == tau && rankA < need) || sa == 0 || sa == cur || sa == cur - 1;
            const bool selB = (kb > tau) || (kb == tau && rankB < need) || sb == cur || sb == cur - 1;
            ma = __ballot(selA); mb = __ballot(selB);
        }
        if (lane == 0) { selm[2 * k2] = ma; selm[2 * k2 + 1] = mb; }
    }
    wave_lds_sync();
    const unsigned long long mlo = selm[2 * tk], mhi = selm[2 * tk + 1];
    unsigned long long ulo = 0ull, uhi = 0ull;
#pragma unroll
    for (int k2 = 0; k2 < 8; ++k2) { ulo |= selm[2 * k2]; uhi |= selm[2 * k2 + 1]; }
    const bf16_t* ksb = KSF + ((size_t)g * 1024 + (size_t)(b * S_ >> 5)) * 2048; const bf16_t* vsb = VT1 + ((size_t)g * 1024 + (size_t)(b * S_ >> 5)) * 2048;
    const bf16_t* kwb = P1 + (size_t)(b * S_) * LDP1 + 1792 + g * 64; const bf16_t* vwb = VT1 + ((size_t)(4 + g) * 1024 + (size_t)(b * S_ >> 5)) * 2048;
    {
        f32x16 o0 = zero16(), o1 = zero16(); m = 0.f; l = 0.f; bool seen = false;
        float ubq; { float qq = 0.f;
#pragma unroll
            for (int ks = 0; ks < 4; ++ks)
#pragma unroll
                for (int e = 0; e < 8; ++e) { const float v = bf2f((bf16_t)qf[ks][e]); qq += v * v; }
            qq += __shfl_xor(qq, 32);
            const float k2 = __uint_as_float(__hip_atomic_load(kmx + 64 + b * 8 + 2 * g, __ATOMIC_RELAXED, __HIP_MEMORY_SCOPE_AGENT)) + __uint_as_float(__hip_atomic_load(kmx + 64 + b * 8 + 2 * g + 1, __ATOMIC_RELAXED, __HIP_MEMORY_SCOPE_AGENT));
            ubq = sqrtf(qq * k2 * 1.02f) * C1; }
        bool stop = false;
#pragma unroll 1
        for (int half = 1; half >= 0 && !stop; --half) {
            unsigned long long U = half ? uhi : ulo; const unsigned long long mine = half ? mhi : mlo;
            U = ((unsigned long long)__builtin_amdgcn_readfirstlane((unsigned)(U >> 32)) << 32) | (unsigned long long)__builtin_amdgcn_readfirstlane((unsigned)U);
            while (U) {
                const int bit = 63 - __builtin_clzll(U); U &= ~(1ull << bit);
                const bool colok = (mine >> bit) & 1ull;
                const int kb0 = (bit + 64 * half) * 64;
                if (__all(seen && (ubq - slope2 * (float)(t - (kb0 + 63)) - m < -150.f))) { stop = true; break; }
#pragma unroll 1
                for (int sub = 0; sub < 2; ++sub) { const int kb = kb0 + 32 * sub; if (kb > tmax) break;
                    soft_tile64(ksb + (size_t)(kb >> 5) * 2048, vsb + (size_t)(kb >> 5) * 2048, qf, t - kb, 1 << 30, colok, kb + 31 > t0w, slope2, lane, hf, m, seen, l, o0, o1); }
            }
        }
        l += __shfl_xor(l, 32);
        const float sc = gs / l; of0 += o0 * sc; of1 += o1 * sc;
    }
    {
        f32x16 o0 = zero16(), o1 = zero16(); m = 0.f; l = 0.f; bool seen = false;
        int lo = t0w - 511; if (lo < 0) lo = 0;
        const int kb_lo = lo & ~31, kb_hi = t0w & ~31;
        int lob = t0b - 511; if (lob < 0) lob = 0;
        const int kb_lob = lob & ~31, kb_hib = t0b + 32, nwt = ((kb_hib - kb_lob) >> 5) + 1;
#define NS_WIN_SRC(kb_) (kst ? kwb + (size_t)((kb_) + st_row) * LDP1 + st_ch * 8 : vwb + (size_t)((kb_) >> 5) * 2048 + vfrag_off(st_row, st_ch))
        sreg = *(const u32x4*)NS_WIN_SRC(kb_hib);
        *(u32x4*)(SB + st_dst) = sreg;
        __syncthreads();
#pragma unroll 1
        for (int n = 0; n < nwt; ++n) {
            const int kb = kb_hib - 32 * n;
            if (n + 1 < nwt) sreg = *(const u32x4*)NS_WIN_SRC(kb - 32);
            const unsigned char* B = SB + (n & 1) * NS_BUF;
            if (kb >= kb_lo && kb <= kb_hi) {
                f32x16 sc_ = qk_lds(B, qf, krow, hf);
                float alpha;
                if (soft_core(sc_, -slope2 * (float)(t - kb - 8 * hf), slope2, (kb + 31 > t0w) || (tmax - kb >= 512), t - kb - 8 * hf, 512, m, seen, l, alpha)) { o0 *= alpha; o1 *= alpha; }
                const bf16x8 p0 = pack8(sc_[0], sc_[1], sc_[2], sc_[3], sc_[4], sc_[5], sc_[6], sc_[7]), p1 = pack8(sc_[8], sc_[9], sc_[10], sc_[11], sc_[12], sc_[13], sc_[14], sc_[15]);
                pv_lds(B, p0, p1, o0, o1, r, hf);
            }
            if (n + 1 < nwt) *(u32x4*)(SB + ((n + 1) & 1) * NS_BUF + st_dst) = sreg;
            __syncthreads();
        }
#undef NS_WIN_SRC
        l += __shfl_xor(l, 32);
        const float sc = gwn / l; of0 += o0 * sc; of1 += o1 * sc;
    }
    store_o64(O + (size_t)(b * S_ + t) * DM + head * 64, of0, of1, hf);
}
DI void phase_nsa(const Params& p, unsigned char* lds, int wave, int lane, int rep = 0) {
    const bf16_t* P1 = (const bf16_t*)(p.ws + WS_BIG); const bf16_t* VT1 = (const bf16_t*)(p.ws + WS_VT);
    const bf16_t* KC = (const bf16_t*)(p.ws + WS_KC); const bf16_t* VCT = (const bf16_t*)(p.ws + WS_VCT); bf16_t* O = (bf16_t*)(p.ws + WS_XN);
    unsigned* qctr = (unsigned*)(p.ws + WS_QCTR) + 8 + rep;
    volatile unsigned* qidx = (volatile unsigned*)(lds + NS_BASE + 2 * NS_BUF);
    for (;;) {
        if (threadIdx.x == 0) qidx[0] = atomicAdd(qctr, 1u);
        __syncthreads();
        const unsigned idx = qidx[0];
        __syncthreads();
        if (idx >= 2048u) break;
        const int bg = idx & 15, tile = 127 - (int)(idx >> 4);
        nsa_block(P1, VT1, (const bf16_t*)(p.ws + WS_KSF), KC, VCT, O, (const unsigned*)(p.ws + WS_KMX), bg >> 2, bg & 3, tile * 64, wave, lane, lds);
    }
}

#define XB_TMO      128
#define XB_XCNT(j)  (256  + 64 * (j))
#define XB_XSUB(j)  (1280 + 64 * (j))
#define XB_XGEN(j)  (2304 + 64 * (j))
#define XB_TOP      3328
#define XB_TOPGEN   3392
#define XCD_BAR_WORDS 3456
#define XB_SPIN_CAP (1u << 18)
#define LAS __attribute__((address_space(3)))

__device__ __forceinline__ unsigned xb_ld(unsigned* p)              { return __hip_atomic_load(p, __ATOMIC_RELAXED, __HIP_MEMORY_SCOPE_AGENT); }
__device__ __forceinline__ unsigned xb_add(unsigned* p, unsigned v) { return __hip_atomic_fetch_add(p, v, __ATOMIC_RELAXED, __HIP_MEMORY_SCOPE_AGENT); }
__device__ __forceinline__ unsigned xb_xcc_id() { return (unsigned)__builtin_amdgcn_s_getreg((3 << 11) | 20) & 0xFu; }
#define XB_SPIN(cond, bar) do { unsigned _sp = 0; while (cond) { __builtin_amdgcn_s_sleep(1); \
    if ((++_sp & 255u) == 0u) { if (xb_ld(&(bar)[XB_TMO])) break; if (_sp > XB_SPIN_CAP) { atomicAdd(&(bar)[XB_TMO], 1u); break; } } } } while (0)

struct XcdBarrier {
    unsigned* bar; unsigned x;
    volatile LAS unsigned* st;
};

__device__ __forceinline__ XcdBarrier xcd_barrier_post(unsigned* bar, volatile LAS unsigned* st) {
    XcdBarrier b; b.bar = bar; b.x = xb_xcc_id(); b.st = st;
    if (threadIdx.x == 0) (void)xb_add(&bar[XB_XCNT(b.x)], 1u);
    return b;
}
__device__ __forceinline__ void xcd_barrier_complete(unsigned* bar, unsigned x, unsigned& nloc, unsigned& nx) {
    const unsigned G = gridDim.x * gridDim.y * gridDim.z;
    unsigned sum, cnt, mine, sp = 0u;
    for (;;) {
        sum = 0u; cnt = 0u; mine = 0u;
#pragma unroll
        for (unsigned j = 0; j < 16; ++j) { const unsigned c = xb_ld(&bar[XB_XCNT(j)]); sum += c; cnt += (c > 0u) ? 1u : 0u; mine = (j == x) ? c : mine; }
        if (sum == G) break;
        __builtin_amdgcn_s_sleep(1);
        if ((++sp & 255u) == 0u) { if (xb_ld(&bar[XB_TMO])) break; if (sp > XB_SPIN_CAP) { atomicAdd(&bar[XB_TMO], 1u); break; } }
    }
    nloc = mine > 0u ? mine : 1u; nx = cnt > 0u ? cnt : 1u;
}

__device__ __forceinline__ void xcd_barrier(const XcdBarrier& b) {
    asm volatile("s_waitcnt vmcnt(0)" ::: "memory");
    __syncthreads();
    if (threadIdx.x == 0) {
        unsigned* bar = b.bar;
        __builtin_amdgcn_s_waitcnt(0);
        unsigned nloc = b.st[0], nx = b.st[1];
        if (nloc == 0u) { xcd_barrier_complete(bar, b.x, nloc, nx); b.st[0] = nloc; b.st[1] = nx; }
        const unsigned old = xb_add(&bar[XB_XSUB(b.x)], 1u);
        const unsigned gen = old / nloc;
        if (old + 1u == (gen + 1u) * nloc) {
            __builtin_amdgcn_fence(__ATOMIC_RELEASE, "agent");
            asm volatile("s_waitcnt vmcnt(0)" ::: "memory");
            const unsigned og = xb_add(&bar[XB_TOP], 1u);
            const unsigned tg = og / nx;
            if (og + 1u == (tg + 1u) * nx) xb_add(&bar[XB_TOPGEN], 1u);
            else XB_SPIN(xb_ld(&bar[XB_TOPGEN]) == tg, bar);
            __builtin_amdgcn_fence(__ATOMIC_ACQUIRE, "agent");
            xb_add(&bar[XB_XGEN(b.x)], 1u);
            asm volatile("s_waitcnt vmcnt(0)" ::: "memory");
        } else {
            XB_SPIN(xb_ld(&bar[XB_XGEN(b.x)]) == gen, bar);
            __builtin_amdgcn_fence(__ATOMIC_ACQUIRE, "agent");
            asm volatile("s_waitcnt vmcnt(0)" ::: "memory");
        }
    }
    __syncthreads();
}

static_assert(XCD_BAR_WORDS * 4 == 13824, "queue counter sits right behind the barrier words");
DI void rs_for_units(int M, int N, bool by_col, const float* SS, float* RS) {
    pg8::StaticOrder S; S.init(M, N, (int)gridDim.x, (int)blockIdx.x);
    pg8::Unit u; int last = -1; const int tid = threadIdx.x;
    for (int i = 0; S.next(i, u); ++i) {
        const int panel = by_col ? u.pn : u.pm;
        if (panel == last) continue;
        last = panel;
        const int row = panel * 256 + (tid >> 1);
        const f32x4* pp = (const f32x4*)(SS + (size_t)row * 16 + (tid & 1) * 8);
        const f32x4 a = pp[0], b = pp[1];
        float v = ((a[0] + a[1]) + (a[2] + a[3])) + ((b[0] + b[1]) + (b[2] + b[3]));
        v += __shfl_xor(v, 1);
        if ((tid & 1) == 0) RS[row] = rsqrtf(v * (1.f / DM) + RMS_EPS);
    }
    asm volatile("s_waitcnt vmcnt(0)" ::: "memory");
    __syncthreads();
}
template <class Epi> DI void run_gemm(unsigned char* lds, const bf16_t* A, const bf16_t* Bt, int M, int N, int K, const Epi& E) {
    pg8::Gemm g{A, Bt, M, N, K}; pg8::StaticOrder S; S.init(M, N, (int)gridDim.x, (int)blockIdx.x);
    pg8::gemm_phase<Epi, pg8::StaticOrder, true, true>((PG8_LAS unsigned char*)lds, g, S, E);
}
#ifndef PROBE_DUP
#define PROBE_DUP 0
#endif
#ifndef ONLY_PHASE
#define ONLY_PHASE -1
#endif
#define PH_EN(n) (ONLY_PHASE < 0 || ONLY_PHASE == (n))
constexpr int NPHASE = 16;
__global__ void __launch_bounds__(512) trunk_fwd(Params p) {
    extern __shared__ __attribute__((aligned(16))) unsigned char lds[];
    cg::grid_group grid = cg::this_grid();
    const int tid = threadIdx.x, lane = tid & 63, wave = __builtin_amdgcn_readfirstlane(tid >> 6);
    const int gw = blockIdx.x * 8 + wave, ngw = gridDim.x * 8;
    unsigned char* ws = p.ws;
    bf16_t* XN = (bf16_t*)(ws + WS_XN); bf16_t* BIG = (bf16_t*)(ws + WS_BIG); bf16_t* VT = (bf16_t*)(ws + WS_VT);
    const int lo = p.ph_lo, hi = p.ph_hi;
    if (hi > 1000) grid.sync();
    if (tid < 4) ((unsigned*)(lds + LDS_GEMM))[tid] = 0u;
    __syncthreads();
    XcdBarrier xbar = xcd_barrier_post((unsigned*)(ws + WS_BAR), (volatile LAS unsigned*)(lds + LDS_GEMM));
#define IN(k) (PH_EN(k) && lo <= (k) && (k) < hi)
#define SEAM(k) do { if ((k) + 1 < hi) { _Pragma("nounroll") for (int rep_ = 0; rep_ < (PROBE_DUP == 99 ? 3 : 1); ++rep_) xcd_barrier(xbar); } } while (0)
    if (IN(0)) {
#pragma nounroll
        for (int rep = 0; rep < (PROBE_DUP == 100 ? 2 : 1); ++rep) phase_prologue(p, lds, wave, lane);
        SEAM(0); }
    bf16_t* XB = (bf16_t*)(ws + WS_XB); float* SS = (float*)(ws + WS_SS); float* RS = (float*)(ws + WS_RS);
#define RSTD_PASS() do { for (int r4 = gw * 4; r4 < T_; r4 += ngw * 4) { float v = SS[(size_t)r4 * 16 + lane]; v += __shfl_xor(v, 1); v += __shfl_xor(v, 2); v += __shfl_xor(v, 4); v += __shfl_xor(v, 8); if ((lane & 15) == 0) RS[r4 + (lane >> 4)] = rsqrtf(v * (1.f / DM) + RMS_EPS); } } while (0)
    if (IN(1)) { run_gemm(lds, XB, (const bf16_t*)(ws + WS_W0QK), T_, 2048, DM, pg8::EpiB<0, true, 1>{BIG, LDP0, (unsigned*)(ws + WS_KMX), 6, 8, RS, nullptr, -1});
                 run_gemm(lds, (const bf16_t*)(ws + WS_W0V), XB, 1024, T_, DM, pg8::EpiB<0, false, 2, true>{VT, T_, nullptr, 0, 0, RS, nullptr, -1}); SEAM(1); }
    if (IN(2)) {
#pragma nounroll
        for (int rep = 0; rep < (PROBE_DUP == 2 ? 2 : 1); ++rep) phase_attn0(p, lds, wave, lane, rep);
        SEAM(2); }
    if (IN(3)) { run_gemm(lds, XN, (const bf16_t*)(ws + WS_W0O), T_, DM, DM, pg8::EpiRb<true>{XB, DM, SS}); SEAM(3); }
    if (IN(5)) { rs_for_units(T_, FF, false, SS, RS);
                 run_gemm(lds, XB, (const bf16_t*)(ws + WS_WM1), T_, FF, DM, pg8::EpiB<1, false, 1>{BIG, FF, nullptr, 0, 0, RS, nullptr, -1}); SEAM(5); }
    if (IN(6)) { run_gemm(lds, BIG, (const bf16_t*)(ws + WS_WM2), T_, DM, FF, pg8::EpiRb<true>{XB, DM, SS}); SEAM(6); }
    if (IN(8)) { rs_for_units(T_, LDP1, false, SS, RS); rs_for_units(512, T_, true, SS, RS);
                 run_gemm(lds, XB, (const bf16_t*)(ws + WS_W1A), T_, LDP1, DM, pg8::EpiB<0, true, 1>{BIG, LDP1, (unsigned*)(ws + WS_KMX) + 64, 6, 7, RS, (bf16_t*)(ws + WS_KSF), 6});
                 run_gemm(lds, (const bf16_t*)(ws + WS_W1V), XB, 512, T_, DM, pg8::EpiB<0, false, 2, true>{VT, T_, nullptr, 0, 0, RS, nullptr, -1}); SEAM(8); }
    if (IN(9)) {
#pragma nounroll
        for (int rep = 0; rep < (PROBE_DUP == 9 ? 2 : 1); ++rep) phase_compress(p, lds, wave, lane);
        SEAM(9); }
    if (IN(10)) {
#pragma nounroll
        for (int rep = 0; rep < (PROBE_DUP == 10 ? 2 : 1); ++rep) phase_nsa(p, lds, wave, lane, rep);
        SEAM(10); }
    if (IN(11)) { run_gemm(lds, XN, (const bf16_t*)(ws + WS_W1O), T_, DM, DM, pg8::EpiRb<true>{XB, DM, SS}); SEAM(11); }
    if (IN(13)) { rs_for_units(T_, FF, false, SS, RS);
                  run_gemm(lds, XB, (const bf16_t*)(ws + WS_WM1 + 8 * MiB), T_, FF, DM, pg8::EpiB<1, false, 1>{BIG, FF, nullptr, 0, 0, RS, nullptr, -1}); SEAM(13); }
    if (IN(14)) { run_gemm(lds, BIG, (const bf16_t*)(ws + WS_WM2 + 8 * MiB), T_, DM, FF, pg8::EpiRb<false>{XB, DM, nullptr}); SEAM(14); }
    if (IN(15)) { final_rows(XB, p.in[3], p.out, gw, ngw, lane); }
#undef IN
#undef RSTD_PASS
#undef SEAM
}

#ifndef MK_PER_PHASE
#define MK_PER_PHASE 0
#endif
extern "C" void kernel_launch(void* const* d_in, const int* in_sizes, int n_in, void* d_out, int out_size, void* d_ws, size_t ws_size, hipStream_t stream) {
    static int grid = 0;
    if (grid == 0) {
        int dev = 0, cus = 0, per_cu = 0;
        (void)hipGetDevice(&dev);
        (void)hipDeviceGetAttribute(&cus, hipDeviceAttributeMultiprocessorCount, dev);
        if (hipFuncSetAttribute((const void*)trunk_fwd, hipFuncAttributeMaxDynamicSharedMemorySize, LDS_BYTES) != hipSuccess) fprintf(stderr, "kernel_launch: hipFuncSetAttribute failed\n");
        if (hipOccupancyMaxActiveBlocksPerMultiprocessor(&per_cu, (const void*)trunk_fwd, 512, LDS_BYTES) != hipSuccess || per_cu < 1) { fprintf(stderr, "kernel_launch: occupancy query says %d\n", per_cu); per_cu = 1; }
        (void)hipGetLastError();
        grid = cus * 1;
        if (n_in != 21 || ws_size < WS_END) fprintf(stderr, "kernel_launch: unexpected n_in %d / ws %zu\n", n_in, ws_size);
    }
    (void)hipMemsetAsync((unsigned char*)d_ws + WS_BAR, 0, (XCD_BAR_WORDS + 64) * sizeof(unsigned), stream);
    Params p{};
    for (int i = 0; i < 21; ++i) p.in[i] = (const float*)d_in[i];
    p.out = (float*)d_out; p.ws = (unsigned char*)d_ws;
#if MK_PER_PHASE
    for (int ph = 0; ph < NPHASE; ++ph) { p.ph_lo = ph; p.ph_hi = ph + 1; hipLaunchKernelGGL(trunk_fwd, dim3(grid), dim3(512), LDS_BYTES, stream, p); }
#else
    p.ph_lo = 0; p.ph_hi = NPHASE;
    void* args[] = {&p};
    hipError_t e = hipLaunchCooperativeKernel((const void*)trunk_fwd, dim3(grid), dim3(512), args, LDS_BYTES, stream);
    if (e != hipSuccess) fprintf(stderr, "kernel_launch: cooperative launch failed: %s (grid %d)\n", hipGetErrorString(e), grid);
#endif
}
```
